# Optimizing an MI355X kernel written in HIP

```python
import jax, jax.numpy as jnp
from jax import lax
import numpy as np

D_MODEL = 2048
BATCH = 8
SEQ = 2048
DEPTH = 1

CHUNK = 64
EPS = 1e-6
D_A = D_MODEL // 2
A_HEADS = 8
A_DK = D_A // A_HEADS
A_DV = D_A // A_HEADS
D_B = D_MODEL // 2
CONV_W = 3
N_BRANCH = 2
IN_SIZES = (D_A, D_A, D_A, D_A, D_B, D_B, D_B, D_B)
IN_COLS = sum(IN_SIZES)

kernel_name = "hgrn2_shortconv_gated_hybrid"


def rms_norm(x, gain):
    xf = x.astype(jnp.float32)
    y = xf * lax.rsqrt(jnp.mean(xf * xf, axis=-1, keepdims=True) + EPS)
    return (y * gain.astype(jnp.float32)).astype(x.dtype)


def hgrn2_chunkwise(q, log_f, k, v):
    bsz, s, h, dk = q.shape
    dv = v.shape[-1]
    n = s // CHUNK
    q, log_f, k = (t.reshape(bsz, n, CHUNK, h, dk) for t in (q, log_f, k))
    v = v.reshape(bsz, n, CHUNK, h, dv)
    b = jnp.cumsum(log_f, axis=2)
    b_mid = b[:, :, CHUNK // 2 - 1:CHUNK // 2]
    b_last = b[:, :, CHUNK - 1:]
    q_rel = q * jnp.exp(b - b_mid)
    k_rel = k * jnp.exp(b_mid - b)
    scores = jnp.einsum('bnthd,bnshd->bnhts', q_rel, k_rel)
    causal = jnp.tril(jnp.ones((CHUNK, CHUNK), dtype=bool))
    scores = jnp.where(causal, scores, 0.0)
    o_intra = jnp.einsum('bnhts,bnshv->bnthv', scores, v)
    d_state = jnp.einsum('bnshd,bnshv->bnhdv', k * jnp.exp(b_last - b), v)
    decay = jnp.exp(b_last[:, :, 0])

    def step(state, inp):
        ds_c, dec_c = inp
        return dec_c[..., None] * state + ds_c, state

    state0 = jnp.zeros((bsz, h, dk, dv), jnp.float32)
    _, state_before = lax.scan(step, state0, (jnp.moveaxis(d_state, 1, 0), jnp.moveaxis(decay, 1, 0)))
    state_before = jnp.moveaxis(state_before, 0, 1)
    o_inter = jnp.einsum('bnthd,bnhdv->bnthv', q * jnp.exp(b), state_before)
    return (o_intra + o_inter).reshape(bsz, s, h, dv)


def causal_depthwise_conv(u, w, bias):
    s = u.shape[1]
    up = jnp.pad(u, ((0, 0), (CONV_W - 1, 0), (0, 0)))
    y = bias
    for j in range(CONV_W):
        y = y + w[j] * up[:, j:j + s]
    return y


def setup_inputs(seed: int = 0) -> dict:
    key = jax.random.key(seed)
    ks = jax.random.split(key, 16)
    f32 = jnp.float32
    nrm = lambda k, shape, scale: (jax.random.normal(k, shape, f32) * scale)
    return {
        "x": nrm(ks[0], (BATCH, SEQ, D_MODEL), 1.0),
        "c": nrm(ks[1], (BATCH, D_MODEL), 1.0),
        "w_ada": nrm(ks[2], (DEPTH, D_MODEL, 3 * D_MODEL), D_MODEL ** -0.5),
        "b_ada": nrm(ks[3], (DEPTH, 3 * D_MODEL), 0.02),
        "g_pre": 1.0 + nrm(ks[4], (DEPTH, D_MODEL), 0.02),
        "w_in": nrm(ks[5], (DEPTH, D_MODEL, IN_COLS), D_MODEL ** -0.5),
        "lb_logits": nrm(ks[6], (DEPTH + 1, D_A), 0.1),
        "g_head_a": 1.0 + nrm(ks[7], (DEPTH, A_DV), 0.02),
        "conv_w": nrm(ks[8], (DEPTH, CONV_W, D_B), CONV_W ** -0.5),
        "conv_b": nrm(ks[9], (DEPTH, D_B), 0.02),
        "w_up_a": nrm(ks[10], (DEPTH, D_A, D_MODEL), D_A ** -0.5),
        "w_up_b": nrm(ks[11], (DEPTH, D_B, D_MODEL), D_B ** -0.5),
        "w_merge": nrm(ks[12], (DEPTH, D_MODEL, N_BRANCH * D_MODEL), D_MODEL ** -0.5),
        "b_merge": nrm(ks[13], (DEPTH, N_BRANCH * D_MODEL), 0.02),
        "w_o": nrm(ks[14], (DEPTH, D_MODEL, D_MODEL), D_MODEL ** -0.5),
        "g_post": 1.0 + nrm(ks[15], (DEPTH, D_MODEL), 0.02),
    }


def reference(x, c, w_ada, b_ada, g_pre, w_in, lb_logits, g_head_a, conv_w, conv_b,
              w_up_a, w_up_b, w_merge, b_merge, w_o, g_post):
    bsz, s, _ = x.shape
    split_at = [int(v) for v in np.cumsum(IN_SIZES)[:-1]]
    lb_all = jnp.cumsum(jax.nn.softmax(lb_logits.astype(jnp.float32), axis=0), axis=0)
    c_act = jax.nn.silu(c)
    for l in range(DEPTH):
        mod = jnp.einsum('bd,de->be', c_act, w_ada[l]) + b_ada[l]
        shift, scale, gate = (m[:, None, :] for m in jnp.split(mod, 3, axis=-1))
        h = rms_norm(x, g_pre[l]) * (1.0 + scale) + shift

        proj = jnp.einsum('bsd,de->bse', h, w_in[l])
        q_a, f_a, i_a, z_a, gate_bb, gate_cc, v_b, z_b = jnp.split(proj, split_at, axis=-1)

        lb = lb_all[l]
        f = lb + (1.0 - lb) * jax.nn.sigmoid(f_a.astype(jnp.float32))
        log_f = jnp.log(f)
        k_a = 1.0 - f
        heads = lambda t: t.reshape(bsz, s, A_HEADS, -1)
        o_a = hgrn2_chunkwise(heads(q_a.astype(jnp.float32)), heads(log_f), heads(k_a),
                              heads(i_a.astype(jnp.float32)))
        o_a = rms_norm(o_a, g_head_a[l]).reshape(bsz, s, D_A).astype(x.dtype)
        y_a = o_a * jax.nn.silu(z_a)

        conv_out = causal_depthwise_conv(gate_cc * v_b, conv_w[l], conv_b[l])
        y_b = gate_bb * conv_out * jax.nn.silu(z_b)

        p_a = jnp.einsum('bse,ed->bsd', y_a, w_up_a[l])
        p_b = jnp.einsum('bse,ed->bsd', y_b, w_up_b[l])
        merge = jax.nn.sigmoid(jnp.einsum('bsd,de->bse', h, w_merge[l]) + b_merge[l])
        m_a, m_b = jnp.split(merge, N_BRANCH, axis=-1)
        out = jnp.einsum('bsd,de->bse', m_a * p_a + m_b * p_b, w_o[l])

        x = x + gate * rms_norm(out, g_post[l])
    return x
```

```cpp
#include <hip/hip_runtime.h>
#include <hip/hip_cooperative_groups.h>
#include <cstdio>
namespace cg = cooperative_groups;

#define LAS __attribute__((address_space(3)))
typedef unsigned short bf16_t;
typedef short bf16x8 __attribute__((ext_vector_type(8)));
typedef float f32x4 __attribute__((ext_vector_type(4)));
typedef float f32x2 __attribute__((ext_vector_type(2)));
typedef unsigned u32x4 __attribute__((ext_vector_type(4)));
typedef unsigned u32x2 __attribute__((ext_vector_type(2)));

constexpr int NTOK = 16384, DM = 2048, SEQ = 2048;
constexpr int LDS_BYTES = 131072 + 256;
#define EPSV 1e-6f

struct Params {
    const float *x, *c, *w_ada, *b_ada, *g_pre, *w_in, *lb_logits, *g_head, *conv_w, *conv_b, *w_up_a, *w_up_b, *w_merge, *b_merge, *w_o, *g_post;
    float* out;
    bf16_t *wt1, *wt2, *wt3, *hy, *proj, *merge, *o, *mix, *outpre;
    float *mod, *ssq_h, *ssq_o, *tmp;
    int ph_lo, ph_hi;
    unsigned long long* chk;
    unsigned* bar;
    unsigned char* img;
};

typedef __bf16 bf16x2_t __attribute__((ext_vector_type(2)));
__device__ __forceinline__ unsigned cvt_pk_bf16(float lo, float hi) { const f32x2 v = {lo, hi}; const bf16x2_t r = __builtin_convertvector(v, bf16x2_t); return __builtin_bit_cast(unsigned, r); }
__device__ __forceinline__ float bflo(unsigned w) { return __uint_as_float(w << 16); }
__device__ __forceinline__ float bfhi(unsigned w) { return __uint_as_float(w & 0xffff0000u); }
__device__ __forceinline__ float sigmoidf_(float x) { return __builtin_amdgcn_rcpf(1.0f + __expf(-x)); }
__device__ __forceinline__ float siluf_(float x) { return x * sigmoidf_(x); }

namespace pg8 {
constexpr int BM = 256, BK = 64, HALF = 128, HTB = HALF * BK * 2, STAGE_BYTES = 8 * HTB, NXCD = 8, WGM = 8;
__host__ __device__ __forceinline__ int lds_byte(int r, int c) { const int st = (r >> 4) * 2 + (c >> 5), rr = r & 15, cc = c & 31, ob = rr * 64 + cc * 2; return st * 1024 + (ob ^ (((ob >> 9) & 1) << 5)); }
__host__ __device__ __forceinline__ void stage_rc(int b, int& R, int& C) { const int st = b / 1024, sb = b % 1024, swz = sb ^ (((sb >> 9) & 1) << 5); R = (st >> 1) * 16 + swz / 64; C = (st & 1) * 32 + (swz % 64) / 2; }
__host__ __device__ __forceinline__ int perm32(int rho) { const int n = rho >> 4, i = rho & 15; return 8 * (i >> 2) + 4 * n + (i & 3); }
struct Unit { int pm, pn; };
struct Gemm { const bf16_t* A; const bf16_t* Bt; int M, N, K; };
struct StaticOrder {
    int nM, nN, nwg, G, c, rot;
    __device__ void init(int M, int N, int G_, int c_, int rot_ = 0) { nM = M / BM; nN = N / BM; nwg = nM * nN; G = G_; c = c_; rot = rot_; }
    __device__ bool next(int i, Unit& u) const {
        const long L = (long)i * G + c; if (L >= nwg) return false;
        int wgid = (int)L; { const int q = nwg / NXCD, r = nwg % NXCD, xcd = wgid % NXCD, off = wgid / NXCD; wgid = (xcd < r ? xcd * (q + 1) : r * (q + 1) + (xcd - r) * q) + off; }
        const int nig = WGM * nN, gid = wgid / nig, fm = gid * WGM, gsz = (nM - fm) < WGM ? (nM - fm) : WGM;
        u.pm = fm + ((wgid % nig) % gsz); u.pn = ((wgid % nig) / gsz + rot) % nN; return true;
    }
};

template <class Epi>
__device__ __forceinline__ void gemm_phase(LAS unsigned char* lds, const Gemm g, const StaticOrder& S, const Epi& E) {
    const int tid = threadIdx.x, wid = __builtin_amdgcn_readfirstlane(tid >> 6), lane = tid & 63, wr = wid >> 2, wc = wid & 3, fr = lane & 15, fq = lane >> 4;
    constexpr int KS = Epi::KSPLIT; const int K = g.K, nt = K / BK / KS; const size_t khstep = (size_t)(K / KS) * 2;
    unsigned voffA[2], voffB[2];
#pragma unroll
    for (int i = 0; i < 2; ++i) { int R, C; stage_rc(tid * 16 + i * 8192, R, C); const int Rb = Epi::PERM ? ((R & ~31) + perm32(R & 31)) : R;
        voffA[i] = (unsigned)(R * K + C) * 2u; voffB[i] = (unsigned)(Rb * K + C) * 2u; }
    const size_t kstep = (size_t)(BK * 2);
    const size_t hstep = (size_t)HALF * K * 2;
    const size_t tstep = 2 * hstep;
    const unsigned ldsw = (unsigned)wid * 1024u;
    const int aoff = lds_byte(wr * 64 + fr, fq * 8), boff = lds_byte(wc * 32 + fr, fq * 8);
#define PG8_SA(b, h) (((b) * 2 + (h)) * HTB)
#define PG8_SB(b, h) ((4 + (b) * 2 + (h)) * HTB)
#define PG8_STAGE(bufoff, gbase, voff) do { _Pragma("unroll") for (int _i = 0; _i < 2; ++_i) \
        __builtin_amdgcn_global_load_lds((const unsigned*)((const char*)(gbase) + (voff)[_i]), (LAS unsigned*)(lds + (bufoff) + ldsw + _i * 8192), 16, 0, 0); } while (0)
#define PG8_LDA(dst, b, h) do { _Pragma("unroll") for (int m = 0; m < 4; ++m) _Pragma("unroll") for (int k = 0; k < 2; ++k) dst[m][k] = *(const LAS bf16x8*)(lds + PG8_SA(b, h) + aoff + m * 2048 + k * 1024); } while (0)
#define PG8_LDB(dst, b, h) do { _Pragma("unroll") for (int n = 0; n < 2; ++n) _Pragma("unroll") for (int k = 0; k < 2; ++k) dst[n][k] = *(const LAS bf16x8*)(lds + PG8_SB(b, h) + boff + n * 2048 + k * 1024); } while (0)
#define PG8_MMA(ai, bj, At, Bt) do { __builtin_amdgcn_s_setprio(1); _Pragma("unroll") for (int m = 0; m < 4; ++m) _Pragma("unroll") for (int n = 0; n < 2; ++n) _Pragma("unroll") for (int k = 0; k < 2; ++k) \
        acc[ai][bj][m][n] = __builtin_amdgcn_mfma_f32_16x16x32_bf16(Bt[n][k], At[m][k], acc[ai][bj][m][n], 0, 0, 0); __builtin_amdgcn_s_setprio(0); } while (0)
#define PG8_WAIT_V(n) asm volatile("s_waitcnt vmcnt(" #n ")" ::: "memory")
#define PG8_WAIT_L(n) asm volatile("s_waitcnt lgkmcnt(" #n ")" ::: "memory")
#define PG8_BAR __builtin_amdgcn_s_barrier()
#define PG8_SCHED __builtin_amdgcn_sched_barrier(0)
    Unit cur, nxt; int ui = 0;
    if (!S.next(0, cur)) return;
    f32x4 acc[2][2][4][2];
#pragma unroll
    for (int a = 0; a < 2; ++a)
#pragma unroll
        for (int b = 0; b < 2; ++b)
#pragma unroll
            for (int m = 0; m < 4; ++m)
#pragma unroll
                for (int n = 0; n < 2; ++n) acc[a][b][m][n] = (f32x4){0.f, 0.f, 0.f, 0.f};
    bf16x8 At[4][2], B0[2][2], B1[2][2];
    const char* cA = (const char*)g.A + (size_t)cur.pm * tstep; const char* cB = (const char*)g.Bt + (size_t)cur.pn * tstep;
    PG8_STAGE(PG8_SB(0, 0), cB, voffB); PG8_STAGE(PG8_SA(0, 0), cA, voffA); PG8_STAGE(PG8_SB(0, 1), cB + hstep, voffB); PG8_STAGE(PG8_SA(0, 1), cA + hstep, voffA);
    if (wr == 1) PG8_BAR;
    PG8_WAIT_V(4); PG8_BAR;
    PG8_STAGE(PG8_SB(1, 0), cB + kstep, voffB); PG8_STAGE(PG8_SA(1, 0), cA + kstep, voffA); PG8_STAGE(PG8_SB(1, 1), cB + hstep + kstep, voffB);
    PG8_WAIT_V(6); PG8_BAR;
    auto kloop = [&](const char* cA, const char* cB, const char* nA, const char* nB) __attribute__((always_inline)) {
        for (int t = 0; t < nt; t += 2) {
            const bool last = (t == nt - 2);
            const char* a1 = cA + (size_t)(t + 1) * kstep;
            const char* a2 = last ? nA : cA + (size_t)(t + 2) * kstep; const char* b2 = last ? nB : cB + (size_t)(t + 2) * kstep;
            const char* a3 = a2 + kstep; const char* b3 = b2 + kstep;
            PG8_LDB(B0, 0, 0); PG8_SCHED; PG8_LDA(At, 0, 0); PG8_STAGE(PG8_SA(1, 1), a1 + hstep, voffA);
            PG8_WAIT_L(8); PG8_BAR; PG8_WAIT_L(0); PG8_MMA(0, 0, At, B0); PG8_BAR; PG8_SCHED;
            PG8_LDB(B1, 0, 1); PG8_STAGE(PG8_SB(0, 0), b2, voffB);
            PG8_BAR; PG8_WAIT_L(0); PG8_MMA(0, 1, At, B1); PG8_BAR;
            PG8_LDA(At, 0, 1); PG8_STAGE(PG8_SA(0, 0), a2, voffA);
            PG8_BAR; PG8_WAIT_L(0); PG8_MMA(1, 0, At, B0); PG8_BAR; PG8_SCHED;
            PG8_STAGE(PG8_SB(0, 1), b2 + hstep, voffB);
            PG8_WAIT_V(6); PG8_BAR; PG8_MMA(1, 1, At, B1); PG8_BAR;
            PG8_LDB(B0, 1, 0); PG8_SCHED; PG8_LDA(At, 1, 0); PG8_STAGE(PG8_SA(0, 1), a2 + hstep, voffA);
            PG8_WAIT_L(8); PG8_BAR; PG8_WAIT_L(0); PG8_MMA(0, 0, At, B0); PG8_BAR; PG8_SCHED;
            PG8_LDB(B1, 1, 1); PG8_STAGE(PG8_SB(1, 0), b3, voffB);
            PG8_BAR; PG8_WAIT_L(0); PG8_MMA(0, 1, At, B1); PG8_BAR;
            PG8_LDA(At, 1, 1); PG8_STAGE(PG8_SA(1, 0), a3, voffA);
            PG8_BAR; PG8_WAIT_L(0); PG8_MMA(1, 0, At, B0); PG8_BAR; PG8_SCHED;
            PG8_STAGE(PG8_SB(1, 1), b3 + hstep, voffB);
            PG8_WAIT_V(6); PG8_BAR; PG8_MMA(1, 1, At, B1); PG8_BAR;
        }
    };
    for (;;) {
        const int kh = (KS == 1) ? 0 : (ui % KS), nkh = (KS == 1) ? 0 : ((ui + 1) % KS);
        bool has_next = true; nxt = cur;
        if (nkh == 0) has_next = S.next((ui + 1) / KS, nxt);
        const char* nA = has_next ? (const char*)g.A + (size_t)nxt.pm * tstep + nkh * khstep : cA; const char* nB = has_next ? (const char*)g.Bt + (size_t)nxt.pn * tstep + nkh * khstep : cB;
        kloop(cA, cB, nA, nB);
        E(acc, cur, kh, wr, wc, fr, fq);
        if (!has_next) break;
#pragma unroll
        for (int a = 0; a < 2; ++a)
#pragma unroll
            for (int b = 0; b < 2; ++b)
#pragma unroll
                for (int m = 0; m < 4; ++m)
#pragma unroll
                    for (int n = 0; n < 2; ++n) acc[a][b][m][n] = (f32x4){0.f, 0.f, 0.f, 0.f};
        cur = nxt; cA = nA; cB = nB; ++ui;
    }
    PG8_WAIT_V(0);
    if (wr == 0) PG8_BAR;
    PG8_BAR;
#undef PG8_SA
#undef PG8_SB
#undef PG8_STAGE
#undef PG8_LDA
#undef PG8_LDB
#undef PG8_MMA
#undef PG8_WAIT_V
#undef PG8_WAIT_L
#undef PG8_BAR
#undef PG8_SCHED
}
}
using pg8::Unit;

struct EpiG1 {
    static constexpr bool PERM = true; static constexpr int KSPLIT = 1;
    bf16_t* proj; bf16_t* merge; const float* b_merge; unsigned long long* chk;
    __device__ __forceinline__ void operator()(const f32x4 (&acc)[2][2][4][2], const Unit& u, int kh, int wr, int wc, int fr, int fq) const {
        const int row0 = u.pm * 256 + wr * 64 + fr;
        if (u.pn < 32) {
            const int col0 = u.pn * 256 + wc * 32 + 8 * fq;
#pragma unroll
            for (int ai = 0; ai < 2; ++ai)
#pragma unroll
                for (int m = 0; m < 4; ++m) { bf16_t* rowp = proj + (size_t)(row0 + ai * 128 + m * 16) * 8192 + col0;
#pragma unroll
                    for (int bj = 0; bj < 2; ++bj) { const f32x4 v0 = acc[ai][bj][m][0], v1 = acc[ai][bj][m][1];
                        u32x4 w; w.x = cvt_pk_bf16(v0[0], v0[1]); w.y = cvt_pk_bf16(v0[2], v0[3]); w.z = cvt_pk_bf16(v1[0], v1[1]); w.w = cvt_pk_bf16(v1[2], v1[3]);
                        __builtin_nontemporal_store(w, (u32x4*)(rowp + bj * 128)); } }
        } else {
            const int col0 = (u.pn - 32) * 256 + wc * 32 + 8 * fq;
            bf16_t* tb = merge + ((size_t)(u.pm * 16 + (u.pn - 32)) * 65536) + (size_t)(wr * 4 + wc) * 8192 + (size_t)(fq * 16 + fr) * 8;
            f32x4 bv[2][2];
#pragma unroll
            for (int bj = 0; bj < 2; ++bj)
#pragma unroll
                for (int n = 0; n < 2; ++n) bv[bj][n] = *(const f32x4*)(b_merge + col0 + bj * 128 + 4 * n);
#pragma unroll
            for (int g = 0; g < 4; ++g) {
#pragma unroll
                for (int j = 0; j < 4; ++j) { const int ai = g >> 1, m = (g & 1) * 2 + (j >> 1), bj = j & 1;
                    f32x4 v0 = acc[ai][bj][m][0] + bv[bj][0], v1 = acc[ai][bj][m][1] + bv[bj][1];
#pragma unroll
                    for (int e = 0; e < 4; ++e) { v0[e] = sigmoidf_(v0[e]); v1[e] = sigmoidf_(v1[e]); }
                    u32x4 w; w.x = cvt_pk_bf16(v0[0], v0[1]); w.y = cvt_pk_bf16(v0[2], v0[3]); w.z = cvt_pk_bf16(v1[0], v1[1]); w.w = cvt_pk_bf16(v1[2], v1[3]);
                    __builtin_nontemporal_store(w, (u32x4*)(tb + j * 512)); }
                tb += 2048; asm volatile("" : "+v"(tb)); }
        }
    }
};
struct EpiG2 {
    static constexpr bool PERM = true; static constexpr int KSPLIT = 2;
    const bf16_t* merge; bf16_t* mix; bf16_t* park;
    __device__ __forceinline__ void operator()(const f32x4 (&acc)[2][2][4][2], const Unit& u, int kh, int wr, int wc, int fr, int fq) const {
        const int row0 = u.pm * 256 + wr * 64 + fr, col0 = u.pn * 256 + wc * 32 + 8 * fq;
        const size_t lo = (size_t)(wr * 4 + wc) * 8192 + (size_t)(fq * 16 + fr) * 8;
        bf16_t* pk = park + (size_t)blockIdx.x * 65536 + lo;
        if (kh == 0) {
            const bf16_t* ta = merge + ((size_t)(u.pm * 16 + u.pn) * 65536) + lo;
#pragma unroll
            for (int g = 0; g < 4; ++g) {
                u32x4 a[4];
#pragma unroll
                for (int j = 0; j < 4; ++j) a[j] = __builtin_nontemporal_load((const u32x4*)(ta + j * 512));
#pragma unroll
                for (int j = 0; j < 4; ++j) { const int ai = g >> 1, m = (g & 1) * 2 + (j >> 1), bj = j & 1; const u32x4 aa = a[j];
                    const f32x4 v0 = acc[ai][bj][m][0], v1 = acc[ai][bj][m][1];
                    u32x4 w; w.x = cvt_pk_bf16(v0[0] * bflo(aa.x), v0[1] * bfhi(aa.x)); w.y = cvt_pk_bf16(v0[2] * bflo(aa.y), v0[3] * bfhi(aa.y));
                    w.z = cvt_pk_bf16(v1[0] * bflo(aa.z), v1[1] * bfhi(aa.z)); w.w = cvt_pk_bf16(v1[2] * bflo(aa.w), v1[3] * bfhi(aa.w));
                    *(u32x4*)(pk + j * 512) = w; }
                ta += 2048; pk += 2048; asm volatile("" : "+v"(ta), "+v"(pk)); }
        } else {
            const bf16_t* tbm = merge + ((size_t)(u.pm * 16 + 8 + u.pn) * 65536) + lo;
            bf16_t* mp = mix + (size_t)row0 * 2048 + col0;
#pragma unroll
            for (int g = 0; g < 8; ++g) {
                u32x4 b[2], t[2];
#pragma unroll
                for (int j = 0; j < 2; ++j) { b[j] = __builtin_nontemporal_load((const u32x4*)(tbm + ((g & 1) * 2 + j) * 512)); t[j] = *(const u32x4*)(pk + ((g & 1) * 2 + j) * 512); }
#pragma unroll
                for (int j = 0; j < 2; ++j) { const int ai = g >> 2, m = g & 3, bj = j; const u32x4 bb = b[j], tt = t[j];
                    const f32x4 v0 = acc[ai][bj][m][0], v1 = acc[ai][bj][m][1];
                    u32x4 w; w.x = cvt_pk_bf16(bflo(tt.x) + v0[0] * bflo(bb.x), bfhi(tt.x) + v0[1] * bfhi(bb.x)); w.y = cvt_pk_bf16(bflo(tt.y) + v0[2] * bflo(bb.y), bfhi(tt.y) + v0[3] * bfhi(bb.y));
                    w.z = cvt_pk_bf16(bflo(tt.z) + v1[0] * bflo(bb.z), bfhi(tt.z) + v1[1] * bfhi(bb.z)); w.w = cvt_pk_bf16(bflo(tt.w) + v1[2] * bflo(bb.w), bfhi(tt.w) + v1[3] * bfhi(bb.w));
                    *(u32x4*)(mp + bj * 128) = w; }
                if (g & 1) { tbm += 2048; pk += 2048; }
                mp += (g == 3) ? (size_t)(128 - 48) * 2048 : (size_t)16 * 2048;
                asm volatile("" : "+v"(tbm), "+v"(pk), "+v"(mp)); }
        }
    }
};
struct EpiG3 {
    static constexpr bool PERM = true; static constexpr int KSPLIT = 1;
    bf16_t* outpre; float* ssq;
    __device__ __forceinline__ void operator()(const f32x4 (&acc)[2][2][4][2], const Unit& u, int kh, int wr, int wc, int fr, int fq) const {
        const int row0 = u.pm * 256 + wr * 64 + fr, col0 = u.pn * 256 + wc * 32 + 8 * fq;
#pragma unroll
        for (int ai = 0; ai < 2; ++ai)
#pragma unroll
            for (int m = 0; m < 4; ++m) { const size_t r = (size_t)(row0 + ai * 128 + m * 16); float s = 0.f;
#pragma unroll
                for (int bj = 0; bj < 2; ++bj) { const f32x4 v0 = acc[ai][bj][m][0], v1 = acc[ai][bj][m][1];
                    s += v0[0] * v0[0] + v0[1] * v0[1] + v0[2] * v0[2] + v0[3] * v0[3] + v1[0] * v1[0] + v1[1] * v1[1] + v1[2] * v1[2] + v1[3] * v1[3];
                    u32x4 w; w.x = cvt_pk_bf16(v0[0], v0[1]); w.y = cvt_pk_bf16(v0[2], v0[3]); w.z = cvt_pk_bf16(v1[0], v1[1]); w.w = cvt_pk_bf16(v1[2], v1[3]);
                    *(u32x4*)(outpre + r * 2048 + col0 + bj * 128) = w; }
                s += __shfl_xor(s, 16); s += __shfl_xor(s, 32);
                if (fq == 0) ssq[r * 32 + u.pn * 4 + wc] = s; }
    }
};

__device__ __forceinline__ void gemv_item(const Params& p, int item, unsigned char* lds) {
    const int tid = threadIdx.x;
    float* cact = (float*)lds;
    float* red = (float*)(lds + 65536);
    for (int i = tid; i < 8 * 2048; i += 512) cact[(i & 2047) * 8 + (i >> 11)] = siluf_(p.c[i]);
    __syncthreads();
    const int col = tid & 31, dg = tid >> 5;
    const float* wp = p.w_ada + (size_t)dg * 6144 + item * 32 + col;
    f32x4 a0 = {0.f, 0.f, 0.f, 0.f}, a1 = {0.f, 0.f, 0.f, 0.f};
#pragma unroll 16
    for (int i = 0; i < 128; ++i) { const float w = __builtin_nontemporal_load(wp + (size_t)i * 16 * 6144); const int d = dg + 16 * i;
        const f32x4 c0 = *(const f32x4*)(cact + d * 8), c1 = *(const f32x4*)(cact + d * 8 + 4);
        a0 += c0 * w; a1 += c1 * w; }
    red[(dg * 8 + 0) * 32 + col] = a0[0]; red[(dg * 8 + 1) * 32 + col] = a0[1]; red[(dg * 8 + 2) * 32 + col] = a0[2]; red[(dg * 8 + 3) * 32 + col] = a0[3];
    red[(dg * 8 + 4) * 32 + col] = a1[0]; red[(dg * 8 + 5) * 32 + col] = a1[1]; red[(dg * 8 + 6) * 32 + col] = a1[2]; red[(dg * 8 + 7) * 32 + col] = a1[3];
    __syncthreads();
    if (tid < 256) { const int b = tid >> 5, c = tid & 31; float s = 0.f;
#pragma unroll
        for (int g = 0; g < 16; ++g) s += red[(g * 8 + b) * 32 + c];
        p.mod[b * 6144 + item * 32 + c] = s + p.b_ada[item * 32 + c]; }
    __syncthreads();
}
__device__ __forceinline__ void transpose_tile(const float* src, int N, int k0, int n0, bf16_t* dst, int dst_ld, int koff) {
    const int lane = threadIdx.x & 63, wid = threadIdx.x >> 6;
    const float* sp = src + (size_t)(k0 + wid * 32) * N + n0 + lane;
    float v[32];
#pragma unroll
    for (int i = 0; i < 32; ++i) v[i] = __builtin_nontemporal_load(sp + (size_t)i * N);
    bf16_t* dp = dst + (size_t)(n0 + lane) * dst_ld + koff + k0 + wid * 32;
#pragma unroll
    for (int c = 0; c < 4; ++c) { u32x4 w; w.x = cvt_pk_bf16(v[c * 8 + 0], v[c * 8 + 1]); w.y = cvt_pk_bf16(v[c * 8 + 2], v[c * 8 + 3]); w.z = cvt_pk_bf16(v[c * 8 + 4], v[c * 8 + 5]); w.w = cvt_pk_bf16(v[c * 8 + 6], v[c * 8 + 7]);
        *(u32x4*)(dp + c * 8) = w; }
}
__device__ __forceinline__ void transpose_item(const Params& p, int id) {
    if (id < 1024) { transpose_tile(p.w_in, 8192, (id >> 7) * 256, (id & 127) * 64, p.wt1, 2048, 0); }
    else if (id < 1536) { id -= 1024; transpose_tile(p.w_merge, 4096, (id >> 6) * 256, (id & 63) * 64, p.wt1 + (size_t)8192 * 2048, 2048, 0); }
    else if (id < 1664) { id -= 1536; transpose_tile(p.w_up_a, 2048, (id >> 5) * 256, (id & 31) * 64, p.wt2, 2048, 0); }
    else if (id < 1792) { id -= 1664; transpose_tile(p.w_up_b, 2048, (id >> 5) * 256, (id & 31) * 64, p.wt2, 2048, 1024); }
    else { id -= 1792; transpose_tile(p.w_o, 2048, (id >> 5) * 256, (id & 31) * 64, p.wt3, 2048, 0); }
}
__device__ __forceinline__ void phase0(const Params& p, unsigned char* lds) {
    constexpr int NG = 192, NTL = 2048;
    if (gridDim.x == 256) {
        const int c = blockIdx.x;
        if (c < NG) { gemv_item(p, c, lds); for (int i = 0; i < 7; ++i) transpose_item(p, c * 7 + i); }
        else { for (int i = 0; i < 11; ++i) transpose_item(p, NG * 7 + (c - NG) * 11 + i); }
    } else {
        for (int item = blockIdx.x; item < NG + NTL; item += gridDim.x) { if (item < NG) gemv_item(p, item, lds); else transpose_item(p, item - NG); }
    }
}

__device__ __forceinline__ void phase1(const Params& p) {
    const int tid = threadIdx.x, wid = tid >> 6, lane = tid & 63;
    const int gw = blockIdx.x * 8 + wid, nw = gridDim.x * 8;
    for (int r0 = gw * 8; r0 < NTOK; r0 += nw * 8) {
        const int b = r0 >> 11; const float* md = p.mod + b * 6144;
        f32x4 gs[8], sh[8];
#pragma unroll
        for (int i = 0; i < 8; ++i) { const int c = i * 256 + lane * 4; const f32x4 g = *(const f32x4*)(p.g_pre + c), sc = *(const f32x4*)(md + 2048 + c);
            sh[i] = *(const f32x4*)(md + c); gs[i] = g * (1.0f + sc); }
        for (int j = 0; j < 8; ++j) { const size_t row = (size_t)(r0 + j); f32x4 xv[8]; float ss = 0.f;
#pragma unroll
            for (int i = 0; i < 8; ++i) { xv[i] = __builtin_nontemporal_load((const f32x4*)(p.x + row * DM + i * 256 + lane * 4)); ss += xv[i][0] * xv[i][0] + xv[i][1] * xv[i][1] + xv[i][2] * xv[i][2] + xv[i][3] * xv[i][3]; }
#pragma unroll
            for (int o = 1; o < 64; o <<= 1) ss += __shfl_xor(ss, o);
            const float rstd = rsqrtf(ss * (1.0f / DM) + EPSV);
#pragma unroll
            for (int i = 0; i < 8; ++i) { const f32x4 hv = xv[i] * rstd * gs[i] + sh[i];
                u32x2 w; w.x = cvt_pk_bf16(hv[0], hv[1]); w.y = cvt_pk_bf16(hv[2], hv[3]);
                *(u32x2*)(p.hy + row * DM + i * 256 + lane * 4) = w; } }
    }
}

constexpr int IMG_BYTES = 41472;
__device__ __forceinline__ void phase3a(const Params& p, unsigned char* lds) {
    const int tid = threadIdx.x, wid = __builtin_amdgcn_readfirstlane(tid >> 6), lane = tid & 63, l15 = lane & 15, q4 = lane >> 4;
    constexpr int RSD = 272;
    unsigned char* QR = lds;
    unsigned char* KR = QR + 17408;
    float* SEG = (float*)(KR + 17408);
    const int d0 = 2 * lane;
    auto map_ch = [&](int ch0) { return (gridDim.x == 256) ? ((ch0 & 7) * 256 + (ch0 >> 8) * 32 + ((ch0 >> 3) & 31)) : ch0; };
    auto load_in = [&](int ch, unsigned (&ff)[8], unsigned (&qq)[8]) __attribute__((always_inline)) {
        const int b = ch >> 8, n = (ch >> 3) & 31, h = ch & 7;
        const bf16_t* base = p.proj + (size_t)(b * SEQ + n * 64 + wid * 8) * 8192 + h * 128 + d0;
#pragma unroll
        for (int i = 0; i < 8; ++i) { ff[i] = __builtin_nontemporal_load((const unsigned*)(base + 1024 + (size_t)i * 8192)); qq[i] = __builtin_nontemporal_load((const unsigned*)(base + (size_t)i * 8192)); }
    };
    auto item_body = [&](int ch, const unsigned (&ff)[8], const unsigned (&qq)[8]) __attribute__((always_inline)) {
        const int h = ch & 7;
        float lb0, lb1;
        { const float l00 = p.lb_logits[h * 128 + d0], l01 = p.lb_logits[h * 128 + d0 + 1], l10 = p.lb_logits[1024 + h * 128 + d0], l11 = p.lb_logits[1024 + h * 128 + d0 + 1];
          lb0 = 1.0f / (1.0f + expf(l10 - l00)); lb1 = 1.0f / (1.0f + expf(l11 - l01)); }
        const float om0 = 1.0f - lb0, om1 = 1.0f - lb1;
        unsigned char* img = p.img + (size_t)ch * IMG_BYTES;
        float cp[8][2], kk[8][2], qv[8][2];
        float run0 = 1.f, run1 = 1.f;
#pragma unroll
        for (int i = 0; i < 8; ++i) {
            const float s0 = sigmoidf_(bflo(ff[i])), s1 = sigmoidf_(bfhi(ff[i]));
            const float f0 = lb0 + om0 * s0, f1 = lb1 + om1 * s1;
            run0 *= f0; run1 *= f1; cp[i][0] = run0; cp[i][1] = run1;
            kk[i][0] = 1.0f - f0; kk[i][1] = 1.0f - f1;
            qv[i][0] = bflo(qq[i]); qv[i][1] = bfhi(qq[i]); }
        *(f32x2*)(SEG + wid * 128 + d0) = (f32x2){run0, run1};
        __syncthreads();
        float pre0 = 1.f, pre1 = 1.f, mid0 = 1.f, mid1 = 1.f, las0 = 1.f, las1 = 1.f;
#pragma unroll
        for (int w = 0; w < 8; ++w) { const f32x2 sg = *(const f32x2*)(SEG + w * 128 + d0);
            if (w < wid) { pre0 *= sg.x; pre1 *= sg.y; } if (w < 4) { mid0 *= sg.x; mid1 *= sg.y; } las0 *= sg.x; las1 *= sg.y; }
        const float rmid0 = __builtin_amdgcn_rcpf(mid0), rmid1 = __builtin_amdgcn_rcpf(mid1);
        unsigned klt0[4], klt1[4];
#pragma unroll
        for (int i = 0; i < 8; i += 2) {
            float kl[2][2];
#pragma unroll
            for (int ii = 0; ii < 2; ++ii) {
                const float P0 = pre0 * cp[i + ii][0], P1 = pre1 * cp[i + ii][1];
                const float rP0 = __builtin_amdgcn_rcpf(P0), rP1 = __builtin_amdgcn_rcpf(P1);
                const float qb0 = qv[i + ii][0] * P0, qb1 = qv[i + ii][1] * P1;
                const float kp0 = kk[i + ii][0] * rP0, kp1 = kk[i + ii][1] * rP1;
                kl[ii][0] = kp0 * las0; kl[ii][1] = kp1 * las1;
                const int t = wid * 8 + i + ii;
                *(unsigned*)(QR + t * RSD + d0 * 2) = cvt_pk_bf16(qb0 * rmid0, qb1 * rmid1);
                *(unsigned*)(KR + t * RSD + d0 * 2) = cvt_pk_bf16(kp0 * mid0, kp1 * mid1);
                *(unsigned*)(img + t * 256 + d0 * 2) = cvt_pk_bf16(qb0, qb1);
            }
            klt0[i >> 1] = cvt_pk_bf16(kl[0][0], kl[1][0]); klt1[i >> 1] = cvt_pk_bf16(kl[0][1], kl[1][1]);
        }
        *(u32x4*)(img + 16384 + d0 * 128 + wid * 16) = (u32x4){klt0[0], klt0[1], klt0[2], klt0[3]};
        *(u32x4*)(img + 16384 + (d0 + 1) * 128 + wid * 16) = (u32x4){klt1[0], klt1[1], klt1[2], klt1[3]};
        if (wid == 0) *(f32x2*)(img + 40960 + d0 * 4) = (f32x2){las0, las1};
        __syncthreads();
        const int tt = wid >> 1;
#pragma unroll
        for (int s2 = 0; s2 < 2; ++s2) { const int st = (wid & 1) * 2 + s2;
            f32x4 pacc = (f32x4){0.f, 0.f, 0.f, 0.f};
            if (st <= tt) {
#pragma unroll
                for (int ks = 0; ks < 4; ++ks) { const bf16x8 a = *(const bf16x8*)(KR + (st * 16 + l15) * RSD + (ks * 32 + q4 * 8) * 2), bb = *(const bf16x8*)(QR + (tt * 16 + l15) * RSD + (ks * 32 + q4 * 8) * 2);
                    pacc = __builtin_amdgcn_mfma_f32_16x16x32_bf16(a, bb, pacc, 0, 0, 0); } }
            const int t = tt * 16 + l15, sb = st * 16 + q4 * 4;
            const float v0 = (sb + 0 <= t) ? pacc[0] : 0.f, v1 = (sb + 1 <= t) ? pacc[1] : 0.f, v2 = (sb + 2 <= t) ? pacc[2] : 0.f, v3 = (sb + 3 <= t) ? pacc[3] : 0.f;
            u32x2 w; w.x = cvt_pk_bf16(v0, v1); w.y = cvt_pk_bf16(v2, v3);
            *(u32x2*)(img + 32768 + t * 128 + sb * 2) = w; }
    };
    if (gridDim.x == 256) {
        unsigned fa[8], qa[8], fb[8], qb[8];
        load_in(map_ch(blockIdx.x), fa, qa);
#pragma unroll
        for (int k = 0; k < 8; k += 2) {
            load_in(map_ch(blockIdx.x + (k + 1) * 256), fb, qb);
            item_body(map_ch(blockIdx.x + k * 256), fa, qa);
            if (k + 2 < 8) load_in(map_ch(blockIdx.x + (k + 2) * 256), fa, qa);
            item_body(map_ch(blockIdx.x + (k + 1) * 256), fb, qb);
        }
    } else {
        for (int ch0 = blockIdx.x; ch0 < 2048; ch0 += gridDim.x) { unsigned fa[8], qa[8]; load_in(ch0, fa, qa); item_body(ch0, fa, qa); }
    }
}
__device__ __forceinline__ void phase3s(const Params& p, unsigned char* lds) {
    const int tid = threadIdx.x, wid = __builtin_amdgcn_readfirstlane(tid >> 6), lane = tid & 63, l15 = lane & 15, q4 = lane >> 4;
    constexpr int RSD = 272, RSS = 144, IMGL = 49664;
    unsigned char* ST = lds + 2 * IMGL;
    for (int item0 = blockIdx.x; item0 < 256; item0 += gridDim.x) {
        const int item = (gridDim.x == 256) ? ((((item0 & 7) * 8 + (item0 >> 5)) << 2) | ((item0 >> 3) & 3)) : item0;
        const int b = item >> 5, h = (item >> 2) & 7, vs = item & 3;
        const bf16_t* vp = p.proj + (size_t)(b * SEQ) * 8192 + 2048 + h * 128 + vs * 32 + (tid & 7) * 4 + (size_t)(tid >> 3) * 8192;
        const unsigned char* img0 = p.img + (size_t)((b * 32) * 8 + h) * IMG_BYTES;
        for (int i = tid; i < 2 * 8704 / 4; i += 512) ((unsigned*)ST)[i] = 0u;
        f32x4 sacc[4];
#pragma unroll
        for (int i = 0; i < 4; ++i) sacc[i] = (f32x4){0.f, 0.f, 0.f, 0.f};
        u32x4 rq0[3], rq1[3], rk0[3], rk1[3], rp[3]; f32x4 rdec0[3], rdec1[3]; u32x2 rv[3];
        const int wd = (wid & 3) * 2;
#define P3S_LOAD(S, nn) do { const unsigned char* im = img0 + (size_t)(nn) * 8 * IMG_BYTES; \
            rq0[S] = *(const u32x4*)(im + tid * 16); rq1[S] = *(const u32x4*)(im + 8192 + tid * 16); \
            rk0[S] = *(const u32x4*)(im + 16384 + tid * 16); rk1[S] = *(const u32x4*)(im + 24576 + tid * 16); \
            rp[S] = *(const u32x4*)(im + 32768 + tid * 16); \
            rdec0[S] = *(const f32x4*)(im + 40960 + (16 * wd + q4 * 4) * 4); rdec1[S] = *(const f32x4*)(im + 40960 + (16 * wd + 16 + q4 * 4) * 4); \
            rv[S] = __builtin_nontemporal_load((const u32x2*)(vp + (size_t)(nn) * 64 * 8192)); } while (0)
#define P3S_PUT(S, nn) do { unsigned char* B_ = lds + ((nn) & 1) * IMGL; \
            u32x4 q0 = rq0[S], q1 = rq1[S], k0 = rk0[S], k1 = rk1[S], pm = rp[S]; unsigned vx = rv[S].x, vy = rv[S].y; \
            asm volatile("" : "+v"(q0), "+v"(q1), "+v"(k0), "+v"(k1), "+v"(pm), "+v"(vx), "+v"(vy)); \
            const int pa = tid, pb = tid + 512; \
            *(u32x4*)(B_ + (pa >> 4) * RSD + (pa & 15) * 16) = q0; *(u32x4*)(B_ + (pb >> 4) * RSD + (pb & 15) * 16) = q1; \
            *(u32x4*)(B_ + 17408 + (pa >> 3) * RSS + (pa & 7) * 16) = k0; *(u32x4*)(B_ + 17408 + (pb >> 3) * RSS + (pb & 7) * 16) = k1; \
            *(u32x4*)(B_ + 35840 + (pa >> 3) * RSS + (pa & 7) * 16) = pm; \
            const int t = tid >> 3, v4 = (tid & 7) * 4; \
            *(bf16_t*)(B_ + 45056 + (v4 + 0) * RSS + t * 2) = (bf16_t)(vx & 0xffff); *(bf16_t*)(B_ + 45056 + (v4 + 1) * RSS + t * 2) = (bf16_t)(vx >> 16); \
            *(bf16_t*)(B_ + 45056 + (v4 + 2) * RSS + t * 2) = (bf16_t)(vy & 0xffff); *(bf16_t*)(B_ + 45056 + (v4 + 3) * RSS + t * 2) = (bf16_t)(vy >> 16); } while (0)
#define P3S_STEP(S1, n) do { \
            f32x4 dcur0 = rdec0[(n) % 3], dcur1 = rdec1[(n) % 3]; asm volatile("" : "+v"(dcur0), "+v"(dcur1)); \
            if ((n) + 1 < 32) P3S_PUT(S1, (n) + 1);                       \
            asm volatile("" ::: "memory"); \
            if ((n) + 3 < 32) P3S_LOAD((n) % 3, (n) + 3);                \
            asm volatile("" ::: "memory"); \
            const unsigned char* B_ = lds + ((n) & 1) * IMGL; const unsigned char* QB = B_; const unsigned char* KLT = B_ + 17408; const unsigned char* PM = B_ + 35840; const unsigned char* VT = B_ + 45056; \
            const unsigned char* STc = ST + ((n) & 1) * 8704; unsigned char* STn = ST + (((n) + 1) & 1) * 8704; \
            if (wid < 4) { const int tt = wid; \
                f32x4 oa0 = (f32x4){0.f, 0.f, 0.f, 0.f}, oa1 = (f32x4){0.f, 0.f, 0.f, 0.f}; \
                _Pragma("unroll") for (int ks = 0; ks < 4; ++ks) { const bf16x8 bb = *(const bf16x8*)(QB + (tt * 16 + l15) * RSD + (ks * 32 + q4 * 8) * 2); \
                    const bf16x8 a0 = *(const bf16x8*)(STc + (l15) * RSD + (ks * 32 + q4 * 8) * 2), a1 = *(const bf16x8*)(STc + (16 + l15) * RSD + (ks * 32 + q4 * 8) * 2); \
                    oa0 = __builtin_amdgcn_mfma_f32_16x16x32_bf16(a0, bb, oa0, 0, 0, 0); oa1 = __builtin_amdgcn_mfma_f32_16x16x32_bf16(a1, bb, oa1, 0, 0, 0); } \
                _Pragma("unroll") for (int ks = 0; ks < 2; ++ks) { const bf16x8 bb = *(const bf16x8*)(PM + (tt * 16 + l15) * RSS + (ks * 32 + q4 * 8) * 2); \
                    const bf16x8 a0 = *(const bf16x8*)(VT + (l15) * RSS + (ks * 32 + q4 * 8) * 2), a1 = *(const bf16x8*)(VT + (16 + l15) * RSS + (ks * 32 + q4 * 8) * 2); \
                    oa0 = __builtin_amdgcn_mfma_f32_16x16x32_bf16(a0, bb, oa0, 0, 0, 0); oa1 = __builtin_amdgcn_mfma_f32_16x16x32_bf16(a1, bb, oa1, 0, 0, 0); } \
                const size_t row = (size_t)(b * SEQ + (n) * 64 + tt * 16 + l15); const int col = h * 128 + vs * 32 + q4 * 4; \
                u32x2 w0, w1; w0.x = cvt_pk_bf16(oa0[0], oa0[1]); w0.y = cvt_pk_bf16(oa0[2], oa0[3]); w1.x = cvt_pk_bf16(oa1[0], oa1[1]); w1.y = cvt_pk_bf16(oa1[2], oa1[3]); \
                *(u32x2*)(p.o + row * 1024 + col) = w0; *(u32x2*)(p.o + row * 1024 + col + 16) = w1; \
                float s0 = oa0[0] * oa0[0] + oa0[1] * oa0[1] + oa0[2] * oa0[2] + oa0[3] * oa0[3], s1 = oa1[0] * oa1[0] + oa1[1] * oa1[1] + oa1[2] * oa1[2] + oa1[3] * oa1[3]; \
                s0 += __shfl_xor(s0, 16); s0 += __shfl_xor(s0, 32); s1 += __shfl_xor(s1, 16); s1 += __shfl_xor(s1, 32); \
                if (q4 == 0) *(f32x2*)(p.ssq_h + row * 64 + h * 8 + vs * 2) = (f32x2){s0, s1}; \
            } else { \
                sacc[0] *= dcur0; sacc[1] *= dcur0; sacc[2] *= dcur1; sacc[3] *= dcur1; \
                _Pragma("unroll") for (int ks = 0; ks < 2; ++ks) { \
                    const bf16x8 a0 = *(const bf16x8*)(KLT + (16 * wd + l15) * RSS + (ks * 32 + q4 * 8) * 2), a1 = *(const bf16x8*)(KLT + (16 * wd + 16 + l15) * RSS + (ks * 32 + q4 * 8) * 2); \
                    const bf16x8 b0 = *(const bf16x8*)(VT + (l15) * RSS + (ks * 32 + q4 * 8) * 2), b1 = *(const bf16x8*)(VT + (16 + l15) * RSS + (ks * 32 + q4 * 8) * 2); \
                    sacc[0] = __builtin_amdgcn_mfma_f32_16x16x32_bf16(a0, b0, sacc[0], 0, 0, 0); sacc[1] = __builtin_amdgcn_mfma_f32_16x16x32_bf16(a0, b1, sacc[1], 0, 0, 0); \
                    sacc[2] = __builtin_amdgcn_mfma_f32_16x16x32_bf16(a1, b0, sacc[2], 0, 0, 0); sacc[3] = __builtin_amdgcn_mfma_f32_16x16x32_bf16(a1, b1, sacc[3], 0, 0, 0); } \
                _Pragma("unroll") for (int i = 0; i < 4; ++i) { const int dt = wd + (i >> 1), v2 = i & 1; \
                    u32x2 w; w.x = cvt_pk_bf16(sacc[i][0], sacc[i][1]); w.y = cvt_pk_bf16(sacc[i][2], sacc[i][3]); \
                    *(u32x2*)(STn + (v2 * 16 + l15) * RSD + (16 * dt + q4 * 4) * 2) = w; } \
            } \
            __syncthreads(); } while (0)
        P3S_LOAD(0, 0); P3S_LOAD(1, 1); P3S_LOAD(2, 2);
        P3S_PUT(0, 0);
        __syncthreads();
        _Pragma("unroll") for (int n = 0; n < 32; ++n) { P3S_STEP((n + 1) % 3, n); }
#undef P3S_STEP
#undef P3S_PUT
#undef P3S_LOAD
    }
}

__device__ __forceinline__ void phase3b(const Params& p) {
    const int T = gridDim.x * 512, g = blockIdx.x * 512 + threadIdx.x;
    for (int e = g; e < NTOK * 128; e += T) {
        const size_t r = (size_t)(e >> 7); const int cgp = e & 127, h = cgp >> 4, v0 = (cgp & 15) * 8;
        const u32x4 o8 = __builtin_nontemporal_load((const u32x4*)(p.o + r * 1024 + cgp * 8)), z8 = __builtin_nontemporal_load((const u32x4*)(p.proj + r * 8192 + 3072 + cgp * 8));
        const f32x4 s0 = *(const f32x4*)(p.ssq_h + r * 64 + h * 8), s1 = *(const f32x4*)(p.ssq_h + r * 64 + h * 8 + 4);
        const float ss = (s0[0] + s0[1]) + (s0[2] + s0[3]) + (s1[0] + s1[1]) + (s1[2] + s1[3]);
        const float rstd = rsqrtf(ss * (1.0f / 128.0f) + EPSV);
        const f32x4 g0 = *(const f32x4*)(p.g_head + v0), g1 = *(const f32x4*)(p.g_head + v0 + 4);
        u32x4 w;
        w.x = cvt_pk_bf16(bflo(o8.x) * rstd * g0[0] * siluf_(bflo(z8.x)), bfhi(o8.x) * rstd * g0[1] * siluf_(bfhi(z8.x)));
        w.y = cvt_pk_bf16(bflo(o8.y) * rstd * g0[2] * siluf_(bflo(z8.y)), bfhi(o8.y) * rstd * g0[3] * siluf_(bfhi(z8.y)));
        w.z = cvt_pk_bf16(bflo(o8.z) * rstd * g1[0] * siluf_(bflo(z8.z)), bfhi(o8.z) * rstd * g1[1] * siluf_(bfhi(z8.z)));
        w.w = cvt_pk_bf16(bflo(o8.w) * rstd * g1[2] * siluf_(bflo(z8.w)), bfhi(o8.w) * rstd * g1[3] * siluf_(bfhi(z8.w)));
        *(u32x4*)(p.hy + r * 2048 + cgp * 8) = w;
    }
    for (int e = g; e < (NTOK / 16) * 128; e += T) {
        const int rb = e >> 7, cgp = e & 127, c0 = cgp * 8;
        const size_t r0 = (size_t)rb * 16; const int t0 = (int)(r0 & (SEQ - 1));
        float w0[8], w1[8], w2[8], bs[8], u1[8], u2[8];
#pragma unroll
        for (int j = 0; j < 8; ++j) { w0[j] = p.conv_w[c0 + j]; w1[j] = p.conv_w[1024 + c0 + j]; w2[j] = p.conv_w[2048 + c0 + j]; bs[j] = p.conv_b[c0 + j]; u1[j] = 0.f; u2[j] = 0.f; }
        if (t0 > 0) {
            const u32x4 ga = *(const u32x4*)(p.proj + (r0 - 1) * 8192 + 5120 + c0), va = *(const u32x4*)(p.proj + (r0 - 1) * 8192 + 6144 + c0);
            const u32x4 gb = *(const u32x4*)(p.proj + (r0 - 2) * 8192 + 5120 + c0), vb = *(const u32x4*)(p.proj + (r0 - 2) * 8192 + 6144 + c0);
            u1[0] = bflo(ga.x) * bflo(va.x); u1[1] = bfhi(ga.x) * bfhi(va.x); u1[2] = bflo(ga.y) * bflo(va.y); u1[3] = bfhi(ga.y) * bfhi(va.y);
            u1[4] = bflo(ga.z) * bflo(va.z); u1[5] = bfhi(ga.z) * bfhi(va.z); u1[6] = bflo(ga.w) * bflo(va.w); u1[7] = bfhi(ga.w) * bfhi(va.w);
            u2[0] = bflo(gb.x) * bflo(vb.x); u2[1] = bfhi(gb.x) * bfhi(vb.x); u2[2] = bflo(gb.y) * bflo(vb.y); u2[3] = bfhi(gb.y) * bfhi(vb.y);
            u2[4] = bflo(gb.z) * bflo(vb.z); u2[5] = bfhi(gb.z) * bfhi(vb.z); u2[6] = bflo(gb.w) * bflo(vb.w); u2[7] = bfhi(gb.w) * bfhi(vb.w);
        }
#pragma unroll 4
        for (int i = 0; i < 16; ++i) {
            const bf16_t* rp = p.proj + (r0 + i) * 8192 + c0;
            const u32x4 gbb = __builtin_nontemporal_load((const u32x4*)(rp + 4096)), gcc = __builtin_nontemporal_load((const u32x4*)(rp + 5120)), vbb = __builtin_nontemporal_load((const u32x4*)(rp + 6144)), zb = __builtin_nontemporal_load((const u32x4*)(rp + 7168));
            float u[8], gv[8], zv[8], y[8];
            u[0] = bflo(gcc.x) * bflo(vbb.x); u[1] = bfhi(gcc.x) * bfhi(vbb.x); u[2] = bflo(gcc.y) * bflo(vbb.y); u[3] = bfhi(gcc.y) * bfhi(vbb.y);
            u[4] = bflo(gcc.z) * bflo(vbb.z); u[5] = bfhi(gcc.z) * bfhi(vbb.z); u[6] = bflo(gcc.w) * bflo(vbb.w); u[7] = bfhi(gcc.w) * bfhi(vbb.w);
            gv[0] = bflo(gbb.x); gv[1] = bfhi(gbb.x); gv[2] = bflo(gbb.y); gv[3] = bfhi(gbb.y); gv[4] = bflo(gbb.z); gv[5] = bfhi(gbb.z); gv[6] = bflo(gbb.w); gv[7] = bfhi(gbb.w);
            zv[0] = bflo(zb.x); zv[1] = bfhi(zb.x); zv[2] = bflo(zb.y); zv[3] = bfhi(zb.y); zv[4] = bflo(zb.z); zv[5] = bfhi(zb.z); zv[6] = bflo(zb.w); zv[7] = bfhi(zb.w);
#pragma unroll
            for (int j = 0; j < 8; ++j) { const float cv = bs[j] + w0[j] * u2[j] + w1[j] * u1[j] + w2[j] * u[j]; y[j] = gv[j] * cv * siluf_(zv[j]); u2[j] = u1[j]; u1[j] = u[j]; }
            u32x4 w; w.x = cvt_pk_bf16(y[0], y[1]); w.y = cvt_pk_bf16(y[2], y[3]); w.z = cvt_pk_bf16(y[4], y[5]); w.w = cvt_pk_bf16(y[6], y[7]);
            *(u32x4*)(p.hy + (r0 + i) * 2048 + 1024 + c0) = w;
        }
    }
}

__device__ __forceinline__ void phase6(const Params& p, const float dscale) {
    const int tid = threadIdx.x, wid = tid >> 6, lane = tid & 63;
    const int gw = blockIdx.x * 8 + wid, nw = gridDim.x * 8;
    for (int rowi = gw; rowi < NTOK; rowi += nw) {
        const size_t row = (size_t)rowi; const int b = rowi >> 11;
        float ss = (lane < 32) ? p.ssq_o[row * 32 + lane] : 0.f;
#pragma unroll
        for (int o = 1; o < 64; o <<= 1) ss += __shfl_xor(ss, o);
        const float rstd = rsqrtf(ss * (1.0f / DM) + EPSV);
#pragma unroll
        for (int i = 0; i < 8; ++i) { const int c = i * 256 + lane * 4;
            const f32x4 xv = __builtin_nontemporal_load((const f32x4*)(p.x + row * DM + c)), gt = *(const f32x4*)(p.mod + b * 6144 + 4096 + c), gp = *(const f32x4*)(p.g_post + c);
            const u32x2 ov = __builtin_nontemporal_load((const u32x2*)(p.outpre + row * DM + c));
            f32x4 r;
            r[0] = xv[0] + gt[0] * (bflo(ov.x) * rstd * gp[0]); r[1] = xv[1] + gt[1] * (bfhi(ov.x) * rstd * gp[1]);
            r[2] = xv[2] + gt[2] * (bflo(ov.y) * rstd * gp[2]); r[3] = xv[3] + gt[3] * (bfhi(ov.y) * rstd * gp[3]);
            __builtin_nontemporal_store(r * dscale, (f32x4*)(p.out + row * DM + c)); }
    }
}


#ifndef DIAG
#define DIAG 0
#endif
__device__ __forceinline__ void chk_sum(const void* buf, size_t bytes, unsigned long long* slot) {
    const u32x4* q = (const u32x4*)buf; const size_t n = bytes / 16; unsigned long long s = 0ull;
    for (size_t i = (size_t)blockIdx.x * 512 + threadIdx.x; i < n; i += (size_t)gridDim.x * 512) { const u32x4 v = q[i]; s += (unsigned long long)v.x + 3ull * v.y + 5ull * v.z + 7ull * v.w; }
    for (int o = 32; o; o >>= 1) s += __shfl_xor(s, o);
    if ((threadIdx.x & 63) == 0) atomicAdd(slot, s);
}
#define XB_TMO      128
#define XB_XCNT(j)  (256  + 64 * (j))
#define XB_XSUB(j)  (1280 + 64 * (j))
#define XB_XGEN(j)  (2304 + 64 * (j))
#define XB_TOP      3328
#define XB_TOPGEN   3392
#define XCD_BAR_WORDS 3456
#define XB_SPIN_CAP (1u << 22)
__device__ __forceinline__ unsigned xb_ld(unsigned* p)              { return __hip_atomic_load(p, __ATOMIC_RELAXED, __HIP_MEMORY_SCOPE_AGENT); }
__device__ __forceinline__ unsigned xb_add(unsigned* p, unsigned v) { return __hip_atomic_fetch_add(p, v, __ATOMIC_RELAXED, __HIP_MEMORY_SCOPE_AGENT); }
__device__ __forceinline__ unsigned xb_xcc_id() { return (unsigned)__builtin_amdgcn_s_getreg((3 << 11) | 20) & 0xFu; }
#define XB_SPIN(cond, bar) do { unsigned _sp = 0; while (cond) { __builtin_amdgcn_s_sleep(1); \
    if ((++_sp & 255u) == 0u) { if (xb_ld(&(bar)[XB_TMO])) break; if (_sp > XB_SPIN_CAP) { atomicAdd(&(bar)[XB_TMO], 1u); break; } } } } while (0)
struct XcdBarrier { unsigned* bar; unsigned x; volatile LAS unsigned* st; };
__device__ __forceinline__ XcdBarrier xcd_barrier_post(unsigned* bar, volatile LAS unsigned* st) {
    XcdBarrier b; b.bar = bar; b.x = xb_xcc_id(); b.st = st;
    if (threadIdx.x == 0) (void)xb_add(&bar[XB_XCNT(b.x)], 1u);
    return b;
}
__device__ __forceinline__ void xcd_barrier_complete(unsigned* bar, unsigned x, unsigned& nloc, unsigned& nx) {
    const unsigned G = gridDim.x * gridDim.y * gridDim.z;
    unsigned sum, cnt, mine, sp = 0u;
    for (;;) {
        sum = 0u; cnt = 0u; mine = 0u;
#pragma unroll
        for (unsigned j = 0; j < 16; ++j) { const unsigned c = xb_ld(&bar[XB_XCNT(j)]); sum += c; cnt += (c > 0u) ? 1u : 0u; mine = (j == x) ? c : mine; }
        if (sum == G) break;
        __builtin_amdgcn_s_sleep(1);
        if ((++sp & 255u) == 0u) { if (xb_ld(&bar[XB_TMO])) break; if (sp > XB_SPIN_CAP) { atomicAdd(&bar[XB_TMO], 1u); break; } }
    }
    nloc = mine > 0u ? mine : 1u; nx = cnt > 0u ? cnt : 1u;
}
__device__ __forceinline__ void xcd_barrier(const XcdBarrier& b) {
    asm volatile("s_waitcnt vmcnt(0)" ::: "memory");
    __syncthreads();
    if (threadIdx.x == 0) {
        unsigned* bar = b.bar;
        __builtin_amdgcn_s_waitcnt(0);
        unsigned nloc = b.st[0], nx = b.st[1];
        if (nloc == 0u) { xcd_barrier_complete(bar, b.x, nloc, nx); b.st[0] = nloc; b.st[1] = nx; }
        const unsigned old = xb_add(&bar[XB_XSUB(b.x)], 1u);
        const unsigned gen = old / nloc;
        if (old + 1u == (gen + 1u) * nloc) {
            __builtin_amdgcn_fence(__ATOMIC_RELEASE, "agent");
            asm volatile("s_waitcnt vmcnt(0)" ::: "memory");
            const unsigned og = xb_add(&bar[XB_TOP], 1u);
            const unsigned tg = og / nx;
            if (og + 1u == (tg + 1u) * nx) xb_add(&bar[XB_TOPGEN], 1u);
            else XB_SPIN(xb_ld(&bar[XB_TOPGEN]) == tg, bar);
            __builtin_amdgcn_fence(__ATOMIC_ACQUIRE, "agent");
            xb_add(&bar[XB_XGEN(b.x)], 1u);
            asm volatile("s_waitcnt vmcnt(0)" ::: "memory");
        } else {
            XB_SPIN(xb_ld(&bar[XB_XGEN(b.x)]) == gen, bar);
            __builtin_amdgcn_fence(__ATOMIC_ACQUIRE, "agent");
            asm volatile("s_waitcnt vmcnt(0)" ::: "memory");
        }
    }
    __syncthreads();
}
__device__ __forceinline__ void gsync(cg::grid_group& grid) {
    __builtin_amdgcn_fence(__ATOMIC_RELEASE, "agent");
    asm volatile("s_waitcnt vmcnt(0) lgkmcnt(0)" ::: "memory");
    grid.sync();
    __builtin_amdgcn_fence(__ATOMIC_ACQUIRE, "agent");
    asm volatile("s_waitcnt vmcnt(0)" ::: "memory");
    __syncthreads();
}
__global__ void __launch_bounds__(512, 2) mega(Params p) {
    extern __shared__ __attribute__((aligned(16))) unsigned char shm[];
    cg::grid_group grid = cg::this_grid();
    const bool multi = (p.ph_hi - p.ph_lo) > 1;
    if (p.ph_lo < 0) gsync(grid);
    volatile LAS unsigned* xst = (volatile LAS unsigned*)((LAS unsigned char*)shm + 131072);
    if (threadIdx.x == 0) { xst[0] = 0u; xst[1] = 0u; }
    __syncthreads();
    XcdBarrier xb; xb.bar = p.bar; xb.x = 0; xb.st = xst;
    if (multi) xb = xcd_barrier_post(p.bar, xst);
#define PH(n) if (p.ph_lo <= (n) && (n) < p.ph_hi)
#define GS(n) if (multi && p.ph_lo <= (n) && (n) + 1 < p.ph_hi) xcd_barrier(xb)
    PH(0) phase0(p, shm);
    GS(0);
    PH(1) phase1(p);
    GS(1);
#if DIAG
    if (multi) chk_sum(p.hy, (size_t)NTOK * 2048 * 2, p.chk + 2);
#endif
    PH(2) { pg8::StaticOrder S; S.init(NTOK, 12288, (int)gridDim.x, (int)blockIdx.x); pg8::Gemm g{p.hy, p.wt1, NTOK, 12288, 2048}; EpiG1 E{p.proj, p.merge, p.b_merge, p.chk};
      pg8::gemm_phase<EpiG1>((LAS unsigned char*)shm, g, S, E); }
    GS(2);
#if DIAG
    if (multi) chk_sum(p.proj, (size_t)NTOK * 8192 * 2, p.chk + 3);
#endif
    PH(3) { phase3a(p, shm); if (multi) xcd_barrier(xb); phase3s(p, shm); }
    GS(3);
    PH(4) phase3b(p);
    GS(4);
    PH(5) { pg8::StaticOrder S; S.init(NTOK, 2048, (int)gridDim.x, (int)blockIdx.x); pg8::Gemm g{p.hy, p.wt2, NTOK, 2048, 2048}; EpiG2 E{p.merge, p.mix, (bf16_t*)p.tmp};
      pg8::gemm_phase<EpiG2>((LAS unsigned char*)shm, g, S, E); }
    GS(5);
    PH(6) { pg8::StaticOrder S; S.init(NTOK, 2048, (int)gridDim.x, (int)blockIdx.x); pg8::Gemm g{p.mix, p.wt3, NTOK, 2048, 2048}; EpiG3 E{p.outpre, p.ssq_o};
      pg8::gemm_phase<EpiG3>((LAS unsigned char*)shm, g, S, E); }
    GS(6);
#if DIAG
    float dscale = 1.0f;
    if (multi) {
        chk_sum(p.wt1, (size_t)(12288 + 2048 + 2048) * 2048 * 2, p.chk + 0);
        chk_sum(p.mod, (size_t)8 * 6144 * 4, p.chk + 1);
        chk_sum(p.o, (size_t)NTOK * 1024 * 2, p.chk + 5);
        chk_sum(p.ssq_h, (size_t)NTOK * 64 * 4, p.chk + 6);
        chk_sum(p.hy, (size_t)NTOK * 2048 * 2, p.chk + 7);
        chk_sum(p.mix, (size_t)NTOK * 2048 * 2, p.chk + 8);
        chk_sum(p.outpre, (size_t)NTOK * 2048 * 2, p.chk + 9);
        chk_sum(p.ssq_o, (size_t)NTOK * 32 * 4, p.chk + 10);
        chk_sum(p.merge, (size_t)NTOK * 4096 * 2, p.chk + 4);
        chk_sum(p.b_merge, (size_t)4096 * 4, p.chk + 13);
        gsync(grid);
        if (blockIdx.x == 0 && threadIdx.x == 0) {
            unsigned long long m = 0ull;
            if (p.chk[31] == 0x1234567887654321ull && p.chk[14] != p.chk[16 + 14]) m = 14ull;
            else if (p.chk[31] == 0x1234567887654321ull) { for (int k = 0; k < 11; ++k) if (p.chk[k] != p.chk[16 + k]) { m = (unsigned long long)(k + 1); break; } }
            for (int k = 0; k < 15; ++k) p.chk[16 + k] = p.chk[k];
            p.chk[31] = 0x1234567887654321ull; p.chk[32] = m;
        }
        gsync(grid);
        dscale = 1.0f + 0.2f * (float)__hip_atomic_load(p.chk + 32, __ATOMIC_RELAXED, __HIP_MEMORY_SCOPE_AGENT);
    }
    PH(7) phase6(p, dscale);
#else
    PH(7) phase6(p, 1.0f);
#endif
#undef PH
#undef GS
}

extern "C" void kernel_launch(void* const* d_in, const int* in_sizes, int n_in, void* d_out, int out_size, void* d_ws, size_t ws_size, hipStream_t stream) {
    (void)in_sizes; (void)n_in; (void)out_size;
    Params p{};
    p.x = (const float*)d_in[0]; p.c = (const float*)d_in[1]; p.w_ada = (const float*)d_in[2]; p.b_ada = (const float*)d_in[3]; p.g_pre = (const float*)d_in[4];
    p.w_in = (const float*)d_in[5]; p.lb_logits = (const float*)d_in[6]; p.g_head = (const float*)d_in[7]; p.conv_w = (const float*)d_in[8]; p.conv_b = (const float*)d_in[9];
    p.w_up_a = (const float*)d_in[10]; p.w_up_b = (const float*)d_in[11]; p.w_merge = (const float*)d_in[12]; p.b_merge = (const float*)d_in[13]; p.w_o = (const float*)d_in[14]; p.g_post = (const float*)d_in[15];
    p.out = (float*)d_out;
    unsigned char* ws = (unsigned char*)d_ws; size_t off = 0;
    auto take = [&](size_t bytes) { unsigned char* r = ws + off; off += (bytes + 255) & ~(size_t)255; return r; };
    p.wt1 = (bf16_t*)take((size_t)12288 * 2048 * 2);
    p.wt2 = (bf16_t*)take((size_t)2048 * 2048 * 2);
    p.wt3 = (bf16_t*)take((size_t)2048 * 2048 * 2);
    p.hy = (bf16_t*)take((size_t)NTOK * 2048 * 2);
    p.proj = (bf16_t*)take((size_t)NTOK * 8192 * 2);
    p.o = (bf16_t*)take((size_t)NTOK * 1024 * 2);
    p.mod = (float*)take((size_t)8 * 6144 * 4);
    p.ssq_h = (float*)take((size_t)NTOK * 64 * 4);
    p.ssq_o = (float*)take((size_t)NTOK * 32 * 4);
    p.bar = (unsigned*)take((size_t)XCD_BAR_WORDS * 4);
    p.img = take((size_t)2048 * IMG_BYTES);
    p.chk = (unsigned long long*)take(512);
    if (off > ws_size) return;
    p.merge = (bf16_t*)d_out;
    p.mix = p.proj;
    p.outpre = p.proj + (size_t)NTOK * 2048;
    p.tmp = (float*)(p.proj + (size_t)NTOK * 4096);
    static int grid_blocks = 0;
    if (!grid_blocks) {
        hipFuncSetAttribute((const void*)mega, hipFuncAttributeMaxDynamicSharedMemorySize, LDS_BYTES);
        int dev = 0, cus = 0, per_cu = 0;
        hipGetDevice(&dev);
        hipDeviceGetAttribute(&cus, hipDeviceAttributeMultiprocessorCount, dev);
        hipOccupancyMaxActiveBlocksPerMultiprocessor(&per_cu, mega, 512, LDS_BYTES);
        if (per_cu < 1) per_cu = 1;
        if (per_cu > 1) per_cu = 1;
        grid_blocks = cus * per_cu;
    }
#ifndef N_LAUNCH_SPLIT
#define N_LAUNCH_SPLIT 1
#endif
#if DIAG
    hipMemsetAsync(p.chk, 0, 128, stream);
#endif
    hipMemsetAsync(p.bar, 0, (size_t)XCD_BAR_WORDS * 4, stream);
    if (N_LAUNCH_SPLIT == 1) {
        p.ph_lo = 0; p.ph_hi = 8;
        void* args[] = {&p};
        hipError_t e = hipLaunchCooperativeKernel((void*)mega, dim3(grid_blocks), dim3(512), args, LDS_BYTES, stream);
        if (e != hipSuccess) fprintf(stderr, "cooperative launch failed: %s (grid %d)\n", hipGetErrorString(e), grid_blocks);
    } else {
        for (int ph = 0; ph < 8; ++ph) { p.ph_lo = ph; p.ph_hi = ph + 1; hipLaunchKernelGGL(mega, dim3(grid_blocks), dim3(512), LDS_BYTES, stream, p); }
    }
}
```

```cpp
#include <hip/hip_runtime.h>
#include <hip/hip_cooperative_groups.h>
#include <cstdio>
namespace cg = cooperative_groups;

#define LAS __attribute__((address_space(3)))
typedef unsigned short bf16_t;
typedef short bf16x8 __attribute__((ext_vector_type(8)));
typedef float f32x4 __attribute__((ext_vector_type(4)));
typedef float f32x2 __attribute__((ext_vector_type(2)));
typedef unsigned u32x4 __attribute__((ext_vector_type(4)));
typedef unsigned u32x2 __attribute__((ext_vector_type(2)));

constexpr int NTOK = 16384, DM = 2048, SEQ = 2048;
constexpr int LDS_BYTES = 131072 + 256;
#define EPSV 1e-6f

struct Params {
    const float *x, *c, *w_ada, *b_ada, *g_pre, *w_in, *lb_logits, *g_head, *conv_w, *conv_b, *w_up_a, *w_up_b, *w_merge, *b_merge, *w_o, *g_post;
    float* out;
    bf16_t *wt1, *wt2, *wt3, *hy, *proj, *merge, *o, *mix, *outpre;
    float *mod, *ssq_h, *ssq_o, *tmp;
    int ph_lo, ph_hi;
    unsigned long long* chk;
    unsigned* bar;
    unsigned char* img;
};

typedef __bf16 bf16x2_t __attribute__((ext_vector_type(2)));
__device__ __forceinline__ unsigned cvt_pk_bf16(float lo, float hi) { const f32x2 v = {lo, hi}; const bf16x2_t r = __builtin_convertvector(v, bf16x2_t); return __builtin_bit_cast(unsigned, r); }
__device__ __forceinline__ float bflo(unsigned w) { return __uint_as_float(w << 16); }
__device__ __forceinline__ float bfhi(unsigned w) { return __uint_as_float(w & 0xffff0000u); }
__device__ __forceinline__ float sigmoidf_(float x) { return __builtin_amdgcn_rcpf(1.0f + __expf(-x)); }
__device__ __forceinline__ float siluf_(float x) { return x * sigmoidf_(x); }

namespace pg8 {
constexpr int BM = 256, BK = 64, HALF = 128, HTB = HALF * BK * 2, STAGE_BYTES = 8 * HTB, NXCD = 8, WGM = 8;
__host__ __device__ __forceinline__ int lds_byte(int r, int c) { const int st = (r >> 4) * 2 + (c >> 5), rr = r & 15, cc = c & 31, ob = rr * 64 + cc * 2; return st * 1024 + (ob ^ (((ob >> 9) & 1) << 5)); }
__host__ __device__ __forceinline__ void stage_rc(int b, int& R, int& C) { const int st = b / 1024, sb = b % 1024, swz = sb ^ (((sb >> 9) & 1) << 5); R = (st >> 1) * 16 + swz / 64; C = (st & 1) * 32 + (swz % 64) / 2; }
__host__ __device__ __forceinline__ int perm32(int rho) { const int n = rho >> 4, i = rho & 15; return 8 * (i >> 2) + 4 * n + (i & 3); }
struct Unit { int pm, pn; };
struct Gemm { const bf16_t* A; const bf16_t* Bt; int M, N, K; };
struct StaticOrder {
    int nM, nN, nwg, G, c, rot;
    __device__ void init(int M, int N, int G_, int c_, int rot_ = 0) { nM = M / BM; nN = N / BM; nwg = nM * nN; G = G_; c = c_; rot = rot_; }
    __device__ bool next(int i, Unit& u) const {
        const long L = (long)i * G + c; if (L >= nwg) return false;
        int wgid = (int)L; { const int q = nwg / NXCD, r = nwg % NXCD, xcd = wgid % NXCD, off = wgid / NXCD; wgid = (xcd < r ? xcd * (q + 1) : r * (q + 1) + (xcd - r) * q) + off; }
        const int nig = WGM * nN, gid = wgid / nig, fm = gid * WGM, gsz = (nM - fm) < WGM ? (nM - fm) : WGM;
        u.pm = fm + ((wgid % nig) % gsz); u.pn = ((wgid % nig) / gsz + rot) % nN; return true;
    }
};

template <class Epi>
__device__ __forceinline__ void gemm_phase(LAS unsigned char* lds, const Gemm g, const StaticOrder& S, const Epi& E) {
    const int tid = threadIdx.x, wid = __builtin_amdgcn_readfirstlane(tid >> 6), lane = tid & 63, wr = wid >> 2, wc = wid & 3, fr = lane & 15, fq = lane >> 4;
    constexpr int KS = Epi::KSPLIT; const int K = g.K, nt = K / BK / KS; const size_t khstep = (size_t)(K / KS) * 2;
    unsigned voffA[2], voffB[2];
#pragma unroll
    for (int i = 0; i < 2; ++i) { int R, C; stage_rc(tid * 16 + i * 8192, R, C); const int Rb = Epi::PERM ? ((R & ~31) + perm32(R & 31)) : R;
        voffA[i] = (unsigned)(R * K + C) * 2u; voffB[i] = (unsigned)(Rb * K + C) * 2u; }
    const size_t kstep = (size_t)(BK * 2);
    const size_t hstep = (size_t)HALF * K * 2;
    const size_t tstep = 2 * hstep;
    const unsigned ldsw = (unsigned)wid * 1024u;
    const int aoff = lds_byte(wr * 64 + fr, fq * 8), boff = lds_byte(wc * 32 + fr, fq * 8);
#define PG8_SA(b, h) (((b) * 2 + (h)) * HTB)
#define PG8_SB(b, h) ((4 + (b) * 2 + (h)) * HTB)
#define PG8_STAGE(bufoff, gbase, voff) do { _Pragma("unroll") for (int _i = 0; _i < 2; ++_i) \
        __builtin_amdgcn_global_load_lds((const unsigned*)((const char*)(gbase) + (voff)[_i]), (LAS unsigned*)(lds + (bufoff) + ldsw + _i * 8192), 16, 0, 0); } while (0)
#define PG8_LDA(dst, b, h) do { _Pragma("unroll") for (int m = 0; m < 4; ++m) _Pragma("unroll") for (int k = 0; k < 2; ++k) dst[m][k] = *(const LAS bf16x8*)(lds + PG8_SA(b, h) + aoff + m * 2048 + k * 1024); } while (0)
#define PG8_LDB(dst, b, h) do { _Pragma("unroll") for (int n = 0; n < 2; ++n) _Pragma("unroll") for (int k = 0; k < 2; ++k) dst[n][k] = *(const LAS bf16x8*)(lds + PG8_SB(b, h) + boff + n * 2048 + k * 1024); } while (0)
#define PG8_MMA(ai, bj, At, Bt) do { __builtin_amdgcn_s_setprio(1); _Pragma("unroll") for (int m = 0; m < 4; ++m) _Pragma("unroll") for (int n = 0; n < 2; ++n) _Pragma("unroll") for (int k = 0; k < 2; ++k) \
        acc[ai][bj][m][n] = __builtin_amdgcn_mfma_f32_16x16x32_bf16(Bt[n][k], At[m][k], acc[ai][bj][m][n], 0, 0, 0); __builtin_amdgcn_s_setprio(0); } while (0)
#define PG8_WAIT_V(n) asm volatile("s_waitcnt vmcnt(" #n ")" ::: "memory")
#define PG8_WAIT_L(n) asm volatile("s_waitcnt lgkmcnt(" #n ")" ::: "memory")
#define PG8_BAR __builtin_amdgcn_s_barrier()
#define PG8_SCHED __builtin_amdgcn_sched_barrier(0)
    Unit cur, nxt; int ui = 0;
    if (!S.next(0, cur)) return;
    f32x4 acc[2][2][4][2];
#pragma unroll
    for (int a = 0; a < 2; ++a)
#pragma unroll
        for (int b = 0; b < 2; ++b)
#pragma unroll
            for (int m = 0; m < 4; ++m)
#pragma unroll
                for (int n = 0; n < 2; ++n) acc[a][b][m][n] = (f32x4){0.f, 0.f, 0.f, 0.f};
    bf16x8 At[4][2], B0[2][2], B1[2][2];
    const char* cA = (const char*)g.A + (size_t)cur.pm * tstep; const char* cB = (const char*)g.Bt + (size_t)cur.pn * tstep;
    PG8_STAGE(PG8_SB(0, 0), cB, voffB); PG8_STAGE(PG8_SA(0, 0), cA, voffA); PG8_STAGE(PG8_SB(0, 1), cB + hstep, voffB); PG8_STAGE(PG8_SA(0, 1), cA + hstep, voffA);
    if (wr == 1) PG8_BAR;
    PG8_WAIT_V(4); PG8_BAR;
    PG8_STAGE(PG8_SB(1, 0), cB + kstep, voffB); PG8_STAGE(PG8_SA(1, 0), cA + kstep, voffA); PG8_STAGE(PG8_SB(1, 1), cB + hstep + kstep, voffB);
    PG8_WAIT_V(6); PG8_BAR;
    auto kloop = [&](const char* cA, const char* cB, const char* nA, const char* nB) __attribute__((always_inline)) {
        for (int t = 0; t < nt; t += 2) {
            const bool last = (t == nt - 2);
            const char* a1 = cA + (size_t)(t + 1) * kstep;
            const char* a2 = last ? nA : cA + (size_t)(t + 2) * kstep; const char* b2 = last ? nB : cB + (size_t)(t + 2) * kstep;
            const char* a3 = a2 + kstep; const char* b3 = b2 + kstep;
            PG8_LDB(B0, 0, 0); PG8_SCHED; PG8_LDA(At, 0, 0); PG8_STAGE(PG8_SA(1, 1), a1 + hstep, voffA);
            PG8_WAIT_L(8); PG8_BAR; PG8_WAIT_L(0); PG8_MMA(0, 0, At, B0); PG8_BAR; PG8_SCHED;
            PG8_LDB(B1, 0, 1); PG8_STAGE(PG8_SB(0, 0), b2, voffB);
            PG8_BAR; PG8_WAIT_L(0); PG8_MMA(0, 1, At, B1); PG8_BAR;
            PG8_LDA(At, 0, 1); PG8_STAGE(PG8_SA(0, 0), a2, voffA);
            PG8_BAR; PG8_WAIT_L(0); PG8_MMA(1, 0, At, B0); PG8_BAR; PG8_SCHED;
            PG8_STAGE(PG8_SB(0, 1), b2 + hstep, voffB);
            PG8_WAIT_V(6); PG8_BAR; PG8_MMA(1, 1, At, B1); PG8_BAR;
            PG8_LDB(B0, 1, 0); PG8_SCHED; PG8_LDA(At, 1, 0); PG8_STAGE(PG8_SA(0, 1), a2 + hstep, voffA);
            PG8_WAIT_L(8); PG8_BAR; PG8_WAIT_L(0); PG8_MMA(0, 0, At, B0); PG8_BAR; PG8_SCHED;
            PG8_LDB(B1, 1, 1); PG8_STAGE(PG8_SB(1, 0), b3, voffB);
            PG8_BAR; PG8_WAIT_L(0); PG8_MMA(0, 1, At, B1); PG8_BAR;
            PG8_LDA(At, 1, 1); PG8_STAGE(PG8_SA(1, 0), a3, voffA);
            PG8_BAR; PG8_WAIT_L(0); PG8_MMA(1, 0, At, B0); PG8_BAR; PG8_SCHED;
            PG8_STAGE(PG8_SB(1, 1), b3 + hstep, voffB);
            PG8_WAIT_V(6); PG8_BAR; PG8_MMA(1, 1, At, B1); PG8_BAR;
        }
    };
    for (;;) {
        const int kh = (KS == 1) ? 0 : (ui % KS), nkh = (KS == 1) ? 0 : ((ui + 1) % KS);
        bool has_next = true; nxt = cur;
        if (nkh == 0) has_next = S.next((ui + 1) / KS, nxt);
        const char* nA = has_next ? (const char*)g.A + (size_t)nxt.pm * tstep + nkh * khstep : cA; const char* nB = has_next ? (const char*)g.Bt + (size_t)nxt.pn * tstep + nkh * khstep : cB;
        kloop(cA, cB, nA, nB);
        E(acc, cur, kh, wr, wc, fr, fq);
        if (!has_next) break;
#pragma unroll
        for (int a = 0; a < 2; ++a)
#pragma unroll
            for (int b = 0; b < 2; ++b)
#pragma unroll
                for (int m = 0; m < 4; ++m)
#pragma unroll
                    for (int n = 0; n < 2; ++n) acc[a][b][m][n] = (f32x4){0.f, 0.f, 0.f, 0.f};
        cur = nxt; cA = nA; cB = nB; ++ui;
    }
    PG8_WAIT_V(0);
    if (wr == 0) PG8_BAR;
    PG8_BAR;
#undef PG8_SA
#undef PG8_SB
#undef PG8_STAGE
#undef PG8_LDA
#undef PG8_LDB
#undef PG8_MMA
#undef PG8_WAIT_V
#undef PG8_WAIT_L
#undef PG8_BAR
#undef PG8_SCHED
}
}
using pg8::Unit;

struct EpiG1 {
    static constexpr bool PERM = true; static constexpr int KSPLIT = 1;
    bf16_t* proj; bf16_t* merge; const float* b_merge; unsigned long long* chk;
    __device__ __forceinline__ void operator()(const f32x4 (&acc)[2][2][4][2], const Unit& u, int kh, int wr, int wc, int fr, int fq) const {
        const int row0 = u.pm * 256 + wr * 64 + fr;
        if (u.pn < 32) {
            const int col0 = u.pn * 256 + wc * 32 + 8 * fq;
#pragma unroll
            for (int ai = 0; ai < 2; ++ai)
#pragma unroll
                for (int m = 0; m < 4; ++m) { bf16_t* rowp = proj + (size_t)(row0 + ai * 128 + m * 16) * 8192 + col0;
#pragma unroll
                    for (int bj = 0; bj < 2; ++bj) { const f32x4 v0 = acc[ai][bj][m][0], v1 = acc[ai][bj][m][1];
                        u32x4 w; w.x = cvt_pk_bf16(v0[0], v0[1]); w.y = cvt_pk_bf16(v0[2], v0[3]); w.z = cvt_pk_bf16(v1[0], v1[1]); w.w = cvt_pk_bf16(v1[2], v1[3]);
                        __builtin_nontemporal_store(w, (u32x4*)(rowp + bj * 128)); } }
        } else {
            const int col0 = (u.pn - 32) * 256 + wc * 32 + 8 * fq;
            bf16_t* tb = merge + ((size_t)(u.pm * 16 + (u.pn - 32)) * 65536) + (size_t)(wr * 4 + wc) * 8192 + (size_t)(fq * 16 + fr) * 8;
            f32x4 bv[2][2];
#pragma unroll
            for (int bj = 0; bj < 2; ++bj)
#pragma unroll
                for (int n = 0; n < 2; ++n) bv[bj][n] = *(const f32x4*)(b_merge + col0 + bj * 128 + 4 * n);
#pragma unroll
            for (int g = 0; g < 4; ++g) {
#pragma unroll
                for (int j = 0; j < 4; ++j) { const int ai = g >> 1, m = (g & 1) * 2 + (j >> 1), bj = j & 1;
                    f32x4 v0 = acc[ai][bj][m][0] + bv[bj][0], v1 = acc[ai][bj][m][1] + bv[bj][1];
#pragma unroll
                    for (int e = 0; e < 4; ++e) { v0[e] = sigmoidf_(v0[e]); v1[e] = sigmoidf_(v1[e]); }
                    u32x4 w; w.x = cvt_pk_bf16(v0[0], v0[1]); w.y = cvt_pk_bf16(v0[2], v0[3]); w.z = cvt_pk_bf16(v1[0], v1[1]); w.w = cvt_pk_bf16(v1[2], v1[3]);
                    __builtin_nontemporal_store(w, (u32x4*)(tb + j * 512)); }
                tb += 2048; asm volatile("" : "+v"(tb)); }
        }
    }
};
struct EpiG2 {
    static constexpr bool PERM = true; static constexpr int KSPLIT = 2;
    const bf16_t* merge; bf16_t* mix; bf16_t* park;
    __device__ __forceinline__ void operator()(const f32x4 (&acc)[2][2][4][2], const Unit& u, int kh, int wr, int wc, int fr, int fq) const {
        const int row0 = u.pm * 256 + wr * 64 + fr, col0 = u.pn * 256 + wc * 32 + 8 * fq;
        const size_t lo = (size_t)(wr * 4 + wc) * 8192 + (size_t)(fq * 16 + fr) * 8;
        bf16_t* pk = park + (size_t)blockIdx.x * 65536 + lo;
        if (kh == 0) {
            const bf16_t* ta = merge + ((size_t)(u.pm * 16 + u.pn) * 65536) + lo;
#pragma unroll
            for (int g = 0; g < 4; ++g) {
                u32x4 a[4];
#pragma unroll
                for (int j = 0; j < 4; ++j) a[j] = __builtin_nontemporal_load((const u32x4*)(ta + j * 512));
#pragma unroll
                for (int j = 0; j < 4; ++j) { const int ai = g >> 1, m = (g & 1) * 2 + (j >> 1), bj = j & 1; const u32x4 aa = a[j];
                    const f32x4 v0 = acc[ai][bj][m][0], v1 = acc[ai][bj][m][1];
                    u32x4 w; w.x = cvt_pk_bf16(v0[0] * bflo(aa.x), v0[1] * bfhi(aa.x)); w.y = cvt_pk_bf16(v0[2] * bflo(aa.y), v0[3] * bfhi(aa.y));
                    w.z = cvt_pk_bf16(v1[0] * bflo(aa.z), v1[1] * bfhi(aa.z)); w.w = cvt_pk_bf16(v1[2] * bflo(aa.w), v1[3] * bfhi(aa.w));
                    *(u32x4*)(pk + j * 512) = w; }
                ta += 2048; pk += 2048; asm volatile("" : "+v"(ta), "+v"(pk)); }
        } else {
            const bf16_t* tbm = merge + ((size_t)(u.pm * 16 + 8 + u.pn) * 65536) + lo;
            bf16_t* mp = mix + (size_t)row0 * 2048 + col0;
#pragma unroll
            for (int g = 0; g < 8; ++g) {
                u32x4 b[2], t[2];
#pragma unroll
                for (int j = 0; j < 2; ++j) { b[j] = __builtin_nontemporal_load((const u32x4*)(tbm + ((g & 1) * 2 + j) * 512)); t[j] = *(const u32x4*)(pk + ((g & 1) * 2 + j) * 512); }
#pragma unroll
                for (int j = 0; j < 2; ++j) { const int ai = g >> 2, m = g & 3, bj = j; const u32x4 bb = b[j], tt = t[j];
                    const f32x4 v0 = acc[ai][bj][m][0], v1 = acc[ai][bj][m][1];
                    u32x4 w; w.x = cvt_pk_bf16(bflo(tt.x) + v0[0] * bflo(bb.x), bfhi(tt.x) + v0[1] * bfhi(bb.x)); w.y = cvt_pk_bf16(bflo(tt.y) + v0[2] * bflo(bb.y), bfhi(tt.y) + v0[3] * bfhi(bb.y));
                    w.z = cvt_pk_bf16(bflo(tt.z) + v1[0] * bflo(bb.z), bfhi(tt.z) + v1[1] * bfhi(bb.z)); w.w = cvt_pk_bf16(bflo(tt.w) + v1[2] * bflo(bb.w), bfhi(tt.w) + v1[3] * bfhi(bb.w));
                    *(u32x4*)(mp + bj * 128) = w; }
                if (g & 1) { tbm += 2048; pk += 2048; }
                mp += (g == 3) ? (size_t)(128 - 48) * 2048 : (size_t)16 * 2048;
                asm volatile("" : "+v"(tbm), "+v"(pk), "+v"(mp)); }
        }
    }
};
struct EpiG3 {
    static constexpr bool PERM = true; static constexpr int KSPLIT = 1;
    bf16_t* outpre; float* ssq;
    __device__ __forceinline__ void operator()(const f32x4 (&acc)[2][2][4][2], const Unit& u, int kh, int wr, int wc, int fr, int fq) const {
        const int row0 = u.pm * 256 + wr * 64 + fr, col0 = u.pn * 256 + wc * 32 + 8 * fq;
#pragma unroll
        for (int ai = 0; ai < 2; ++ai)
#pragma unroll
            for (int m = 0; m < 4; ++m) { const size_t r = (size_t)(row0 + ai * 128 + m * 16); float s = 0.f;
#pragma unroll
                for (int bj = 0; bj < 2; ++bj) { const f32x4 v0 = acc[ai][bj][m][0], v1 = acc[ai][bj][m][1];
                    s += v0[0] * v0[0] + v0[1] * v0[1] + v0[2] * v0[2] + v0[3] * v0[3] + v1[0] * v1[0] + v1[1] * v1[1] + v1[2] * v1[2] + v1[3] * v1[3];
                    u32x4 w; w.x = cvt_pk_bf16(v0[0], v0[1]); w.y = cvt_pk_bf16(v0[2], v0[3]); w.z = cvt_pk_bf16(v1[0], v1[1]); w.w = cvt_pk_bf16(v1[2], v1[3]);
                    *(u32x4*)(outpre + r * 2048 + col0 + bj * 128) = w; }
                s += __shfl_xor(s, 16); s += __shfl_xor(s, 32);
                if (fq == 0) ssq[r * 32 + u.pn * 4 + wc] = s; }
    }
};

__device__ __forceinline__ void gemv_item(const Params& p, int item, unsigned char* lds) {
    const int tid = threadIdx.x;
    float* cact = (float*)lds;
    float* red = (float*)(lds + 65536);
    for (int i = tid; i < 8 * 2048; i += 512) cact[(i & 2047) * 8 + (i >> 11)] = siluf_(p.c[i]);
    __syncthreads();
    const int col = tid & 31, dg = tid >> 5;
    const float* wp = p.w_ada + (size_t)dg * 6144 + item * 32 + col;
    f32x4 a0 = {0.f, 0.f, 0.f, 0.f}, a1 = {0.f, 0.f, 0.f, 0.f};
#pragma unroll 16
    for (int i = 0; i < 128; ++i) { const float w = __builtin_nontemporal_load(wp + (size_t)i * 16 * 6144); const int d = dg + 16 * i;
        const f32x4 c0 = *(const f32x4*)(cact + d * 8), c1 = *(const f32x4*)(cact + d * 8 + 4);
        a0 += c0 * w; a1 += c1 * w; }
    red[(dg * 8 + 0) * 32 + col] = a0[0]; red[(dg * 8 + 1) * 32 + col] = a0[1]; red[(dg * 8 + 2) * 32 + col] = a0[2]; red[(dg * 8 + 3) * 32 + col] = a0[3];
    red[(dg * 8 + 4) * 32 + col] = a1[0]; red[(dg * 8 + 5) * 32 + col] = a1[1]; red[(dg * 8 + 6) * 32 + col] = a1[2]; red[(dg * 8 + 7) * 32 + col] = a1[3];
    __syncthreads();
    if (tid < 256) { const int b = tid >> 5, c = tid & 31; float s = 0.f;
#pragma unroll
        for (int g = 0; g < 16; ++g) s += red[(g * 8 + b) * 32 + c];
        p.mod[b * 6144 + item * 32 + c] = s + p.b_ada[item * 32 + c]; }
    __syncthreads();
}
__device__ __forceinline__ void transpose_tile(const float* src, int N, int k0, int n0, bf16_t* dst, int dst_ld, int koff) {
    const int lane = threadIdx.x & 63, wid = threadIdx.x >> 6;
    const float* sp = src + (size_t)(k0 + wid * 32) * N + n0 + lane;
    float v[32];
#pragma unroll
    for (int i = 0; i < 32; ++i) v[i] = __builtin_nontemporal_load(sp + (size_t)i * N);
    bf16_t* dp = dst + (size_t)(n0 + lane) * dst_ld + koff + k0 + wid * 32;
#pragma unroll
    for (int c = 0; c < 4; ++c) { u32x4 w; w.x = cvt_pk_bf16(v[c * 8 + 0], v[c * 8 + 1]); w.y = cvt_pk_bf16(v[c * 8 + 2], v[c * 8 + 3]); w.z = cvt_pk_bf16(v[c * 8 + 4], v[c * 8 + 5]); w.w = cvt_pk_bf16(v[c * 8 + 6], v[c * 8 + 7]);
        *(u32x4*)(dp + c * 8) = w; }
}
__device__ __forceinline__ void transpose_item(const Params& p, int id) {
    if (id < 1024) { transpose_tile(p.w_in, 8192, (id >> 7) * 256, (id & 127) * 64, p.wt1, 2048, 0); }
    else if (id < 1536) { id -= 1024; transpose_tile(p.w_merge, 4096, (id >> 6) * 256, (id & 63) * 64, p.wt1 + (size_t)8192 * 2048, 2048, 0); }
    else if (id < 1664) { id -= 1536; transpose_tile(p.w_up_a, 2048, (id >> 5) * 256, (id & 31) * 64, p.wt2, 2048, 0); }
    else if (id < 1792) { id -= 1664; transpose_tile(p.w_up_b, 2048, (id >> 5) * 256, (id & 31) * 64, p.wt2, 2048, 1024); }
    else { id -= 1792; transpose_tile(p.w_o, 2048, (id >> 5) * 256, (id & 31) * 64, p.wt3, 2048, 0); }
}
__device__ __forceinline__ void phase0(const Params& p, unsigned char* lds) {
    constexpr int NG = 192, NTL = 2048;
    if (gridDim.x == 256) {
        const int c = blockIdx.x;
        if (c < NG) { gemv_item(p, c, lds); for (int i = 0; i < 7; ++i) transpose_item(p, c * 7 + i); }
        else { for (int i = 0; i < 11; ++i) transpose_item(p, NG * 7 + (c - NG) * 11 + i); }
    } else {
        for (int item = blockIdx.x; item < NG + NTL; item += gridDim.x) { if (item < NG) gemv_item(p, item, lds); else transpose_item(p, item - NG); }
    }
}

__device__ __forceinline__ void phase1(const Params& p) {
    const int tid = threadIdx.x, wid = tid >> 6, lane = tid & 63;
    const int gw = blockIdx.x * 8 + wid, nw = gridDim.x * 8;
    for (int r0 = gw * 8; r0 < NTOK; r0 += nw * 8) {
        const int b = r0 >> 11; const float* md = p.mod + b * 6144;
        f32x4 gs[8], sh[8];
#pragma unroll
        for (int i = 0; i < 8; ++i) { const int c = i * 256 + lane * 4; const f32x4 g = *(const f32x4*)(p.g_pre + c), sc = *(const f32x4*)(md + 2048 + c);
            sh[i] = *(const f32x4*)(md + c); gs[i] = g * (1.0f + sc); }
        for (int j = 0; j < 8; ++j) { const size_t row = (size_t)(r0 + j); f32x4 xv[8]; float ss = 0.f;
#pragma unroll
            for (int i = 0; i < 8; ++i) { xv[i] = __builtin_nontemporal_load((const f32x4*)(p.x + row * DM + i * 256 + lane * 4)); ss += xv[i][0] * xv[i][0] + xv[i][1] * xv[i][1] + xv[i][2] * xv[i][2] + xv[i][3] * xv[i][3]; }
#pragma unroll
            for (int o = 1; o < 64; o <<= 1) ss += __shfl_xor(ss, o);
            const float rstd = rsqrtf(ss * (1.0f / DM) + EPSV);
#pragma unroll
            for (int i = 0; i < 8; ++i) { const f32x4 hv = xv[i] * rstd * gs[i] + sh[i];
                u32x2 w; w.x = cvt_pk_bf16(hv[0], hv[1]); w.y = cvt_pk_bf16(hv[2], hv[3]);
                *(u32x2*)(p.hy + row * DM + i * 256 + lane * 4) = w; } }
    }
}

constexpr int IMG_BYTES = 41472;
__device__ __forceinline__ void phase3a(const Params& p, unsigned char* lds) {
    const int tid = threadIdx.x, wid = __builtin_amdgcn_readfirstlane(tid >> 6), lane = tid & 63, l15 = lane & 15, q4 = lane >> 4;
    constexpr int RSD = 272;
    unsigned char* QR = lds;
    unsigned char* KR = QR + 17408;
    float* SEG = (float*)(KR + 17408);
    const int d0 = 2 * lane;
    auto map_ch = [&](int ch0) { return (gridDim.x == 256) ? ((ch0 & 7) * 256 + (ch0 >> 8) * 32 + ((ch0 >> 3) & 31)) : ch0; };
    auto load_in = [&](int ch, unsigned (&ff)[8], unsigned (&qq)[8]) __attribute__((always_inline)) {
        const int b = ch >> 8, n = (ch >> 3) & 31, h = ch & 7;
        const bf16_t* base = p.proj + (size_t)(b * SEQ + n * 64 + wid * 8) * 8192 + h * 128 + d0;
#pragma unroll
        for (int i = 0; i < 8; ++i) { ff[i] = __builtin_nontemporal_load((const unsigned*)(base + 1024 + (size_t)i * 8192)); qq[i] = __builtin_nontemporal_load((const unsigned*)(base + (size_t)i * 8192)); }
    };
    auto item_body = [&](int ch, const unsigned (&ff)[8], const unsigned (&qq)[8]) __attribute__((always_inline)) {
        const int h = ch & 7;
        float lb0, lb1;
        { const float l00 = p.lb_logits[h * 128 + d0], l01 = p.lb_logits[h * 128 + d0 + 1], l10 = p.lb_logits[1024 + h * 128 + d0], l11 = p.lb_logits[1024 + h * 128 + d0 + 1];
          lb0 = 1.0f / (1.0f + expf(l10 - l00)); lb1 = 1.0f / (1.0f + expf(l11 - l01)); }
        const float om0 = 1.0f - lb0, om1 = 1.0f - lb1;
        unsigned char* img = p.img + (size_t)ch * IMG_BYTES;
        float cp[8][2], kk[8][2], qv[8][2];
        float run0 = 1.f, run1 = 1.f;
#pragma unroll
        for (int i = 0; i < 8; ++i) {
            const float s0 = sigmoidf_(bflo(ff[i])), s1 = sigmoidf_(bfhi(ff[i]));
            const float f0 = lb0 + om0 * s0, f1 = lb1 + om1 * s1;
            run0 *= f0; run1 *= f1; cp[i][0] = run0; cp[i][1] = run1;
            kk[i][0] = 1.0f - f0; kk[i][1] = 1.0f - f1;
            qv[i][0] = bflo(qq[i]); qv[i][1] = bfhi(qq[i]); }
        *(f32x2*)(SEG + wid * 128 + d0) = (f32x2){run0, run1};
        __syncthreads();
        float pre0 = 1.f, pre1 = 1.f, mid0 = 1.f, mid1 = 1.f, las0 = 1.f, las1 = 1.f;
#pragma unroll
        for (int w = 0; w < 8; ++w) { const f32x2 sg = *(const f32x2*)(SEG + w * 128 + d0);
            if (w < wid) { pre0 *= sg.x; pre1 *= sg.y; } if (w < 4) { mid0 *= sg.x; mid1 *= sg.y; } las0 *= sg.x; las1 *= sg.y; }
        const float rmid0 = __builtin_amdgcn_rcpf(mid0), rmid1 = __builtin_amdgcn_rcpf(mid1);
        unsigned klt0[4], klt1[4];
#pragma unroll
        for (int i = 0; i < 8; i += 2) {
            float kl[2][2];
#pragma unroll
            for (int ii = 0; ii < 2; ++ii) {
                const float P0 = fmaxf(pre0 * cp[i + ii][0], 1e-30f), P1 = fmaxf(pre1 * cp[i + ii][1], 1e-30f);
                const float rP0 = __builtin_amdgcn_rcpf(P0), rP1 = __builtin_amdgcn_rcpf(P1);
                const float qb0 = qv[i + ii][0] * P0, qb1 = qv[i + ii][1] * P1;
                const float kp0 = kk[i + ii][0] * rP0, kp1 = kk[i + ii][1] * rP1;
                kl[ii][0] = kp0 * las0; kl[ii][1] = kp1 * las1;
                const int t = wid * 8 + i + ii;
                *(unsigned*)(QR + t * RSD + d0 * 2) = cvt_pk_bf16(qb0 * rmid0, qb1 * rmid1);
                *(unsigned*)(KR + t * RSD + d0 * 2) = cvt_pk_bf16(kp0 * mid0, kp1 * mid1);
                *(unsigned*)(img + t * 256 + d0 * 2) = cvt_pk_bf16(qb0, qb1);
            }
            klt0[i >> 1] = cvt_pk_bf16(kl[0][0], kl[1][0]); klt1[i >> 1] = cvt_pk_bf16(kl[0][1], kl[1][1]);
        }
        *(u32x4*)(img + 16384 + d0 * 128 + wid * 16) = (u32x4){klt0[0], klt0[1], klt0[2], klt0[3]};
        *(u32x4*)(img + 16384 + (d0 + 1) * 128 + wid * 16) = (u32x4){klt1[0], klt1[1], klt1[2], klt1[3]};
        if (wid == 0) *(f32x2*)(img + 40960 + d0 * 4) = (f32x2){las0, las1};
        __syncthreads();
        const int tt = wid >> 1;
#pragma unroll
        for (int s2 = 0; s2 < 2; ++s2) { const int st = (wid & 1) * 2 + s2;
            f32x4 pacc = (f32x4){0.f, 0.f, 0.f, 0.f};
            if (st <= tt) {
#pragma unroll
                for (int ks = 0; ks < 4; ++ks) { const bf16x8 a = *(const bf16x8*)(KR + (st * 16 + l15) * RSD + (ks * 32 + q4 * 8) * 2), bb = *(const bf16x8*)(QR + (tt * 16 + l15) * RSD + (ks * 32 + q4 * 8) * 2);
                    pacc = __builtin_amdgcn_mfma_f32_16x16x32_bf16(a, bb, pacc, 0, 0, 0); } }
            const int t = tt * 16 + l15, sb = st * 16 + q4 * 4;
            const float v0 = (sb + 0 <= t) ? pacc[0] : 0.f, v1 = (sb + 1 <= t) ? pacc[1] : 0.f, v2 = (sb + 2 <= t) ? pacc[2] : 0.f, v3 = (sb + 3 <= t) ? pacc[3] : 0.f;
            u32x2 w; w.x = cvt_pk_bf16(v0, v1); w.y = cvt_pk_bf16(v2, v3);
            *(u32x2*)(img + 32768 + t * 128 + sb * 2) = w; }
    };
    if (gridDim.x == 256) {
        unsigned fa[8], qa[8], fb[8], qb[8];
        load_in(map_ch(blockIdx.x), fa, qa);
#pragma unroll
        for (int k = 0; k < 8; k += 2) {
            load_in(map_ch(blockIdx.x + (k + 1) * 256), fb, qb);
            item_body(map_ch(blockIdx.x + k * 256), fa, qa);
            if (k + 2 < 8) load_in(map_ch(blockIdx.x + (k + 2) * 256), fa, qa);
            item_body(map_ch(blockIdx.x + (k + 1) * 256), fb, qb);
        }
    } else {
        for (int ch0 = blockIdx.x; ch0 < 2048; ch0 += gridDim.x) { unsigned fa[8], qa[8]; load_in(ch0, fa, qa); item_body(ch0, fa, qa); }
    }
}
__device__ __forceinline__ void phase3s(const Params& p, unsigned char* lds) {
    const int tid = threadIdx.x, wid = __builtin_amdgcn_readfirstlane(tid >> 6), lane = tid & 63, l15 = lane & 15, q4 = lane >> 4;
    constexpr int RSD = 272, RSS = 144, IMGL = 49664;
    unsigned char* ST = lds + 2 * IMGL;
    for (int item0 = blockIdx.x; item0 < 256; item0 += gridDim.x) {
        const int item = (gridDim.x == 256) ? ((((item0 & 7) * 8 + (item0 >> 5)) << 2) | ((item0 >> 3) & 3)) : item0;
        const int b = item >> 5, h = (item >> 2) & 7, vs = item & 3;
        const bf16_t* vp = p.proj + (size_t)(b * SEQ) * 8192 + 2048 + h * 128 + vs * 32 + (tid & 7) * 4 + (size_t)(tid >> 3) * 8192;
        const unsigned char* img0 = p.img + (size_t)((b * 32) * 8 + h) * IMG_BYTES;
        for (int i = tid; i < 2 * 8704 / 4; i += 512) ((unsigned*)ST)[i] = 0u;
        f32x4 sacc[4];
#pragma unroll
        for (int i = 0; i < 4; ++i) sacc[i] = (f32x4){0.f, 0.f, 0.f, 0.f};
        u32x4 rq0[3], rq1[3], rk0[3], rk1[3], rp[3]; f32x4 rdec0[3], rdec1[3]; u32x2 rv[3];
        const int wd = (wid & 3) * 2;
#define P3S_LOAD(S, nn) do { const unsigned char* im = img0 + (size_t)(nn) * 8 * IMG_BYTES; \
            rq0[S] = *(const u32x4*)(im + tid * 16); rq1[S] = *(const u32x4*)(im + 8192 + tid * 16); \
            rk0[S] = *(const u32x4*)(im + 16384 + tid * 16); rk1[S] = *(const u32x4*)(im + 24576 + tid * 16); \
            rp[S] = *(const u32x4*)(im + 32768 + tid * 16); \
            rdec0[S] = *(const f32x4*)(im + 40960 + (16 * wd + q4 * 4) * 4); rdec1[S] = *(const f32x4*)(im + 40960 + (16 * wd + 16 + q4 * 4) * 4); \
            rv[S] = __builtin_nontemporal_load((const u32x2*)(vp + (size_t)(nn) * 64 * 8192)); } while (0)
#define P3S_PUT(S, nn) do { unsigned char* B_ = lds + ((nn) & 1) * IMGL; \
            u32x4 q0 = rq0[S], q1 = rq1[S], k0 = rk0[S], k1 = rk1[S], pm = rp[S]; unsigned vx = rv[S].x, vy = rv[S].y; \
            asm volatile("" : "+v"(q0), "+v"(q1), "+v"(k0), "+v"(k1), "+v"(pm), "+v"(vx), "+v"(vy)); \
            const int pa = tid, pb = tid + 512; \
            *(u32x4*)(B_ + (pa >> 4) * RSD + (pa & 15) * 16) = q0; *(u32x4*)(B_ + (pb >> 4) * RSD + (pb & 15) * 16) = q1; \
            *(u32x4*)(B_ + 17408 + (pa >> 3) * RSS + (pa & 7) * 16) = k0; *(u32x4*)(B_ + 17408 + (pb >> 3) * RSS + (pb & 7) * 16) = k1; \
            *(u32x4*)(B_ + 35840 + (pa >> 3) * RSS + (pa & 7) * 16) = pm; \
            const int t = tid >> 3, v4 = (tid & 7) * 4; \
            *(bf16_t*)(B_ + 45056 + (v4 + 0) * RSS + t * 2) = (bf16_t)(vx & 0xffff); *(bf16_t*)(B_ + 45056 + (v4 + 1) * RSS + t * 2) = (bf16_t)(vx >> 16); \
            *(bf16_t*)(B_ + 45056 + (v4 + 2) * RSS + t * 2) = (bf16_t)(vy & 0xffff); *(bf16_t*)(B_ + 45056 + (v4 + 3) * RSS + t * 2) = (bf16_t)(vy >> 16); } while (0)
#define P3S_STEP(S1, n) do { \
            f32x4 dcur0 = rdec0[(n) % 3], dcur1 = rdec1[(n) % 3]; asm volatile("" : "+v"(dcur0), "+v"(dcur1)); \
            if ((n) + 1 < 32) P3S_PUT(S1, (n) + 1);                       \
            asm volatile("" ::: "memory"); \
            if ((n) + 3 < 32) P3S_LOAD((n) % 3, (n) + 3);                \
            asm volatile("" ::: "memory"); \
            const unsigned char* B_ = lds + ((n) & 1) * IMGL; const unsigned char* QB = B_; const unsigned char* KLT = B_ + 17408; const unsigned char* PM = B_ + 35840; const unsigned char* VT = B_ + 45056; \
            const unsigned char* STc = ST + ((n) & 1) * 8704; unsigned char* STn = ST + (((n) + 1) & 1) * 8704; \
            if (wid < 4) { const int tt = wid; \
                f32x4 oa0 = (f32x4){0.f, 0.f, 0.f, 0.f}, oa1 = (f32x4){0.f, 0.f, 0.f, 0.f}; \
                _Pragma("unroll") for (int ks = 0; ks < 4; ++ks) { const bf16x8 bb = *(const bf16x8*)(QB + (tt * 16 + l15) * RSD + (ks * 32 + q4 * 8) * 2); \
                    const bf16x8 a0 = *(const bf16x8*)(STc + (l15) * RSD + (ks * 32 + q4 * 8) * 2), a1 = *(const bf16x8*)(STc + (16 + l15) * RSD + (ks * 32 + q4 * 8) * 2); \
                    oa0 = __builtin_amdgcn_mfma_f32_16x16x32_bf16(a0, bb, oa0, 0, 0, 0); oa1 = __builtin_amdgcn_mfma_f32_16x16x32_bf16(a1, bb, oa1, 0, 0, 0); } \
                _Pragma("unroll") for (int ks = 0; ks < 2; ++ks) { const bf16x8 bb = *(const bf16x8*)(PM + (tt * 16 + l15) * RSS + (ks * 32 + q4 * 8) * 2); \
                    const bf16x8 a0 = *(const bf16x8*)(VT + (l15) * RSS + (ks * 32 + q4 * 8) * 2), a1 = *(const bf16x8*)(VT + (16 + l15) * RSS + (ks * 32 + q4 * 8) * 2); \
                    oa0 = __builtin_amdgcn_mfma_f32_16x16x32_bf16(a0, bb, oa0, 0, 0, 0); oa1 = __builtin_amdgcn_mfma_f32_16x16x32_bf16(a1, bb, oa1, 0, 0, 0); } \
                const size_t row = (size_t)(b * SEQ + (n) * 64 + tt * 16 + l15); const int col = h * 128 + vs * 32 + q4 * 4; \
                u32x2 w0, w1; w0.x = cvt_pk_bf16(oa0[0], oa0[1]); w0.y = cvt_pk_bf16(oa0[2], oa0[3]); w1.x = cvt_pk_bf16(oa1[0], oa1[1]); w1.y = cvt_pk_bf16(oa1[2], oa1[3]); \
                *(u32x2*)(p.o + row * 1024 + col) = w0; *(u32x2*)(p.o + row * 1024 + col + 16) = w1; \
                float s0 = oa0[0] * oa0[0] + oa0[1] * oa0[1] + oa0[2] * oa0[2] + oa0[3] * oa0[3], s1 = oa1[0] * oa1[0] + oa1[1] * oa1[1] + oa1[2] * oa1[2] + oa1[3] * oa1[3]; \
                s0 += __shfl_xor(s0, 16); s0 += __shfl_xor(s0, 32); s1 += __shfl_xor(s1, 16); s1 += __shfl_xor(s1, 32); \
                if (q4 == 0) *(f32x2*)(p.ssq_h + row * 64 + h * 8 + vs * 2) = (f32x2){s0, s1}; \
            } else { \
                sacc[0] *= dcur0; sacc[1] *= dcur0; sacc[2] *= dcur1; sacc[3] *= dcur1; \
                _Pragma("unroll") for (int ks = 0; ks < 2; ++ks) { \
                    const bf16x8 a0 = *(const bf16x8*)(KLT + (16 * wd + l15) * RSS + (ks * 32 + q4 * 8) * 2), a1 = *(const bf16x8*)(KLT + (16 * wd + 16 + l15) * RSS + (ks * 32 + q4 * 8) * 2); \
                    const bf16x8 b0 = *(const bf16x8*)(VT + (l15) * RSS + (ks * 32 + q4 * 8) * 2), b1 = *(const bf16x8*)(VT + (16 + l15) * RSS + (ks * 32 + q4 * 8) * 2); \
                    sacc[0] = __builtin_amdgcn_mfma_f32_16x16x32_bf16(a0, b0, sacc[0], 0, 0, 0); sacc[1] = __builtin_amdgcn_mfma_f32_16x16x32_bf16(a0, b1, sacc[1], 0, 0, 0); \
                    sacc[2] = __builtin_amdgcn_mfma_f32_16x16x32_bf16(a1, b0, sacc[2], 0, 0, 0); sacc[3] = __builtin_amdgcn_mfma_f32_16x16x32_bf16(a1, b1, sacc[3], 0, 0, 0); } \
                _Pragma("unroll") for (int i = 0; i < 4; ++i) { const int dt = wd + (i >> 1), v2 = i & 1; \
                    u32x2 w; w.x = cvt_pk_bf16(sacc[i][0], sacc[i][1]); w.y = cvt_pk_bf16(sacc[i][2], sacc[i][3]); \
                    *(u32x2*)(STn + (v2 * 16 + l15) * RSD + (16 * dt + q4 * 4) * 2) = w; } \
            } \
            __syncthreads(); } while (0)
        P3S_LOAD(0, 0); P3S_LOAD(1, 1); P3S_LOAD(2, 2);
        P3S_PUT(0, 0);
        __syncthreads();
        _Pragma("unroll") for (int n = 0; n < 32; ++n) { P3S_STEP((n + 1) % 3, n); }
#undef P3S_STEP
#undef P3S_PUT
#undef P3S_LOAD
    }
}

__device__ __forceinline__ void phase3b(const Params& p) {
    const int T = gridDim.x * 512, g = blockIdx.x * 512 + threadIdx.x;
    for (int e = g; e < NTOK * 128; e += T) {
        const size_t r = (size_t)(e >> 7); const int cgp = e & 127, h = cgp >> 4, v0 = (cgp & 15) * 8;
        const u32x4 o8 = __builtin_nontemporal_load((const u32x4*)(p.o + r * 1024 + cgp * 8)), z8 = __builtin_nontemporal_load((const u32x4*)(p.proj + r * 8192 + 3072 + cgp * 8));
        const f32x4 s0 = *(const f32x4*)(p.ssq_h + r * 64 + h * 8), s1 = *(const f32x4*)(p.ssq_h + r * 64 + h * 8 + 4);
        const float ss = (s0[0] + s0[1]) + (s0[2] + s0[3]) + (s1[0] + s1[1]) + (s1[2] + s1[3]);
        const float rstd = rsqrtf(ss * (1.0f / 128.0f) + EPSV);
        const f32x4 g0 = *(const f32x4*)(p.g_head + v0), g1 = *(const f32x4*)(p.g_head + v0 + 4);
        u32x4 w;
        w.x = cvt_pk_bf16(bflo(o8.x) * rstd * g0[0] * siluf_(bflo(z8.x)), bfhi(o8.x) * rstd * g0[1] * siluf_(bfhi(z8.x)));
        w.y = cvt_pk_bf16(bflo(o8.y) * rstd * g0[2] * siluf_(bflo(z8.y)), bfhi(o8.y) * rstd * g0[3] * siluf_(bfhi(z8.y)));
        w.z = cvt_pk_bf16(bflo(o8.z) * rstd * g1[0] * siluf_(bflo(z8.z)), bfhi(o8.z) * rstd * g1[1] * siluf_(bfhi(z8.z)));
        w.w = cvt_pk_bf16(bflo(o8.w) * rstd * g1[2] * siluf_(bflo(z8.w)), bfhi(o8.w) * rstd * g1[3] * siluf_(bfhi(z8.w)));
        *(u32x4*)(p.hy + r * 2048 + cgp * 8) = w;
    }
    for (int e = g; e < (NTOK / 16) * 128; e += T) {
        const int rb = e >> 7, cgp = e & 127, c0 = cgp * 8;
        const size_t r0 = (size_t)rb * 16; const int t0 = (int)(r0 & (SEQ - 1));
        float w0[8], w1[8], w2[8], bs[8], u1[8], u2[8];
#pragma unroll
        for (int j = 0; j < 8; ++j) { w0[j] = p.conv_w[c0 + j]; w1[j] = p.conv_w[1024 + c0 + j]; w2[j] = p.conv_w[2048 + c0 + j]; bs[j] = p.conv_b[c0 + j]; u1[j] = 0.f; u2[j] = 0.f; }
        if (t0 > 0) {
            const u32x4 ga = *(const u32x4*)(p.proj + (r0 - 1) * 8192 + 5120 + c0), va = *(const u32x4*)(p.proj + (r0 - 1) * 8192 + 6144 + c0);
            const u32x4 gb = *(const u32x4*)(p.proj + (r0 - 2) * 8192 + 5120 + c0), vb = *(const u32x4*)(p.proj + (r0 - 2) * 8192 + 6144 + c0);
            u1[0] = bflo(ga.x) * bflo(va.x); u1[1] = bfhi(ga.x) * bfhi(va.x); u1[2] = bflo(ga.y) * bflo(va.y); u1[3] = bfhi(ga.y) * bfhi(va.y);
            u1[4] = bflo(ga.z) * bflo(va.z); u1[5] = bfhi(ga.z) * bfhi(va.z); u1[6] = bflo(ga.w) * bflo(va.w); u1[7] = bfhi(ga.w) * bfhi(va.w);
            u2[0] = bflo(gb.x) * bflo(vb.x); u2[1] = bfhi(gb.x) * bfhi(vb.x); u2[2] = bflo(gb.y) * bflo(vb.y); u2[3] = bfhi(gb.y) * bfhi(vb.y);
            u2[4] = bflo(gb.z) * bflo(vb.z); u2[5] = bfhi(gb.z) * bfhi(vb.z); u2[6] = bflo(gb.w) * bflo(vb.w); u2[7] = bfhi(gb.w) * bfhi(vb.w);
        }
#pragma unroll 4
        for (int i = 0; i < 16; ++i) {
            const bf16_t* rp = p.proj + (r0 + i) * 8192 + c0;
            const u32x4 gbb = __builtin_nontemporal_load((const u32x4*)(rp + 4096)), gcc = __builtin_nontemporal_load((const u32x4*)(rp + 5120)), vbb = __builtin_nontemporal_load((const u32x4*)(rp + 6144)), zb = __builtin_nontemporal_load((const u32x4*)(rp + 7168));
            float u[8], gv[8], zv[8], y[8];
            u[0] = bflo(gcc.x) * bflo(vbb.x); u[1] = bfhi(gcc.x) * bfhi(vbb.x); u[2] = bflo(gcc.y) * bflo(vbb.y); u[3] = bfhi(gcc.y) * bfhi(vbb.y);
            u[4] = bflo(gcc.z) * bflo(vbb.z); u[5] = bfhi(gcc.z) * bfhi(vbb.z); u[6] = bflo(gcc.w) * bflo(vbb.w); u[7] = bfhi(gcc.w) * bfhi(vbb.w);
            gv[0] = bflo(gbb.x); gv[1] = bfhi(gbb.x); gv[2] = bflo(gbb.y); gv[3] = bfhi(gbb.y); gv[4] = bflo(gbb.z); gv[5] = bfhi(gbb.z); gv[6] = bflo(gbb.w); gv[7] = bfhi(gbb.w);
            zv[0] = bflo(zb.x); zv[1] = bfhi(zb.x); zv[2] = bflo(zb.y); zv[3] = bfhi(zb.y); zv[4] = bflo(zb.z); zv[5] = bfhi(zb.z); zv[6] = bflo(zb.w); zv[7] = bfhi(zb.w);
#pragma unroll
            for (int j = 0; j < 8; ++j) { const float cv = bs[j] + w0[j] * u2[j] + w1[j] * u1[j] + w2[j] * u[j]; y[j] = gv[j] * cv * siluf_(zv[j]); u2[j] = u1[j]; u1[j] = u[j]; }
            u32x4 w; w.x = cvt_pk_bf16(y[0], y[1]); w.y = cvt_pk_bf16(y[2], y[3]); w.z = cvt_pk_bf16(y[4], y[5]); w.w = cvt_pk_bf16(y[6], y[7]);
            *(u32x4*)(p.hy + (r0 + i) * 2048 + 1024 + c0) = w;
        }
    }
}

__device__ __forceinline__ void phase6(const Params& p, const float dscale) {
    const int tid = threadIdx.x, wid = tid >> 6, lane = tid & 63;
    const int gw = blockIdx.x * 8 + wid, nw = gridDim.x * 8;
    for (int rowi = gw; rowi < NTOK; rowi += nw) {
        const size_t row = (size_t)rowi; const int b = rowi >> 11;
        float ss = (lane < 32) ? p.ssq_o[row * 32 + lane] : 0.f;
#pragma unroll
        for (int o = 1; o < 64; o <<= 1) ss += __shfl_xor(ss, o);
        const float rstd = rsqrtf(ss * (1.0f / DM) + EPSV);
#pragma unroll
        for (int i = 0; i < 8; ++i) { const int c = i * 256 + lane * 4;
            const f32x4 xv = __builtin_nontemporal_load((const f32x4*)(p.x + row * DM + c)), gt = *(const f32x4*)(p.mod + b * 6144 + 4096 + c), gp = *(const f32x4*)(p.g_post + c);
            const u32x2 ov = __builtin_nontemporal_load((const u32x2*)(p.outpre + row * DM + c));
            f32x4 r;
            r[0] = xv[0] + gt[0] * (bflo(ov.x) * rstd * gp[0]); r[1] = xv[1] + gt[1] * (bfhi(ov.x) * rstd * gp[1]);
            r[2] = xv[2] + gt[2] * (bflo(ov.y) * rstd * gp[2]); r[3] = xv[3] + gt[3] * (bfhi(ov.y) * rstd * gp[3]);
            __builtin_nontemporal_store(r * dscale, (f32x4*)(p.out + row * DM + c)); }
    }
}


#ifndef DIAG
#define DIAG 0
#endif
__device__ __forceinline__ void chk_sum(const void* buf, size_t bytes, unsigned long long* slot) {
    const u32x4* q = (const u32x4*)buf; const size_t n = bytes / 16; unsigned long long s = 0ull;
    for (size_t i = (size_t)blockIdx.x * 512 + threadIdx.x; i < n; i += (size_t)gridDim.x * 512) { const u32x4 v = q[i]; s += (unsigned long long)v.x + 3ull * v.y + 5ull * v.z + 7ull * v.w; }
    for (int o = 32; o; o >>= 1) s += __shfl_xor(s, o);
    if ((threadIdx.x & 63) == 0) atomicAdd(slot, s);
}
#define XB_TMO      128
#define XB_XCNT(j)  (256  + 64 * (j))
#define XB_XSUB(j)  (1280 + 64 * (j))
#define XB_XGEN(j)  (2304 + 64 * (j))
#define XB_TOP      3328
#define XB_TOPGEN   3392
#define XCD_BAR_WORDS 3456
#define XB_SPIN_CAP (1u << 22)
__device__ __forceinline__ unsigned xb_ld(unsigned* p)              { return __hip_atomic_load(p, __ATOMIC_RELAXED, __HIP_MEMORY_SCOPE_AGENT); }
__device__ __forceinline__ unsigned xb_add(unsigned* p, unsigned v) { return __hip_atomic_fetch_add(p, v, __ATOMIC_RELAXED, __HIP_MEMORY_SCOPE_AGENT); }
__device__ __forceinline__ unsigned xb_xcc_id() { return (unsigned)__builtin_amdgcn_s_getreg((3 << 11) | 20) & 0xFu; }
#define XB_SPIN(cond, bar) do { unsigned _sp = 0; while (cond) { __builtin_amdgcn_s_sleep(1); \
    if ((++_sp & 255u) == 0u) { if (xb_ld(&(bar)[XB_TMO])) break; if (_sp > XB_SPIN_CAP) { atomicAdd(&(bar)[XB_TMO], 1u); break; } } } } while (0)
struct XcdBarrier { unsigned* bar; unsigned x; volatile LAS unsigned* st; };
__device__ __forceinline__ XcdBarrier xcd_barrier_post(unsigned* bar, volatile LAS unsigned* st) {
    XcdBarrier b; b.bar = bar; b.x = xb_xcc_id(); b.st = st;
    if (threadIdx.x == 0) (void)xb_add(&bar[XB_XCNT(b.x)], 1u);
    return b;
}
__device__ __forceinline__ void xcd_barrier_complete(unsigned* bar, unsigned x, unsigned& nloc, unsigned& nx) {
    const unsigned G = gridDim.x * gridDim.y * gridDim.z;
    unsigned sum, cnt, mine, sp = 0u;
    for (;;) {
        sum = 0u; cnt = 0u; mine = 0u;
#pragma unroll
        for (unsigned j = 0; j < 16; ++j) { const unsigned c = xb_ld(&bar[XB_XCNT(j)]); sum += c; cnt += (c > 0u) ? 1u : 0u; mine = (j == x) ? c : mine; }
        if (sum == G) break;
        __builtin_amdgcn_s_sleep(1);
        if ((++sp & 255u) == 0u) { if (xb_ld(&bar[XB_TMO])) break; if (sp > XB_SPIN_CAP) { atomicAdd(&bar[XB_TMO], 1u); break; } }
    }
    nloc = mine > 0u ? mine : 1u; nx = cnt > 0u ? cnt : 1u;
}
__device__ __forceinline__ void xcd_barrier(const XcdBarrier& b) {
    asm volatile("s_waitcnt vmcnt(0)" ::: "memory");
    __syncthreads();
    if (threadIdx.x == 0) {
        unsigned* bar = b.bar;
        __builtin_amdgcn_s_waitcnt(0);
        unsigned nloc = b.st[0], nx = b.st[1];
        if (nloc == 0u) { xcd_barrier_complete(bar, b.x, nloc, nx); b.st[0] = nloc; b.st[1] = nx; }
        const unsigned old = xb_add(&bar[XB_XSUB(b.x)], 1u);
        const unsigned gen = old / nloc;
        if (old + 1u == (gen + 1u) * nloc) {
            __builtin_amdgcn_fence(__ATOMIC_RELEASE, "agent");
            asm volatile("s_waitcnt vmcnt(0)" ::: "memory");
            const unsigned og = xb_add(&bar[XB_TOP], 1u);
            const unsigned tg = og / nx;
            if (og + 1u == (tg + 1u) * nx) xb_add(&bar[XB_TOPGEN], 1u);
            else XB_SPIN(xb_ld(&bar[XB_TOPGEN]) == tg, bar);
            __builtin_amdgcn_fence(__ATOMIC_ACQUIRE, "agent");
            xb_add(&bar[XB_XGEN(b.x)], 1u);
            asm volatile("s_waitcnt vmcnt(0)" ::: "memory");
        } else {
            XB_SPIN(xb_ld(&bar[XB_XGEN(b.x)]) == gen, bar);
            __builtin_amdgcn_fence(__ATOMIC_ACQUIRE, "agent");
            asm volatile("s_waitcnt vmcnt(0)" ::: "memory");
        }
    }
    __syncthreads();
}
__device__ __forceinline__ void gsync(cg::grid_group& grid) {
    __builtin_amdgcn_fence(__ATOMIC_RELEASE, "agent");
    asm volatile("s_waitcnt vmcnt(0) lgkmcnt(0)" ::: "memory");
    grid.sync();
    __builtin_amdgcn_fence(__ATOMIC_ACQUIRE, "agent");
    asm volatile("s_waitcnt vmcnt(0)" ::: "memory");
    __syncthreads();
}
__global__ void __launch_bounds__(512, 2) mega(Params p) {
    extern __shared__ __attribute__((aligned(16))) unsigned char shm[];
    cg::grid_group grid = cg::this_grid();
    const bool multi = (p.ph_hi - p.ph_lo) > 1;
    if (p.ph_lo < 0) gsync(grid);
    volatile LAS unsigned* xst = (volatile LAS unsigned*)((LAS unsigned char*)shm + 131072);
    if (threadIdx.x == 0) { xst[0] = 0u; xst[1] = 0u; }
    __syncthreads();
    XcdBarrier xb; xb.bar = p.bar; xb.x = 0; xb.st = xst;
    if (multi) xb = xcd_barrier_post(p.bar, xst);
#define PH(n) if (p.ph_lo <= (n) && (n) < p.ph_hi)
#define GS(n) if (multi && p.ph_lo <= (n) && (n) + 1 < p.ph_hi) xcd_barrier(xb)
    PH(0) phase0(p, shm);
    GS(0);
    PH(1) phase1(p);
    GS(1);
#if DIAG
    if (multi) chk_sum(p.hy, (size_t)NTOK * 2048 * 2, p.chk + 2);
#endif
    PH(2) { pg8::StaticOrder S; S.init(NTOK, 12288, (int)gridDim.x, (int)blockIdx.x); pg8::Gemm g{p.hy, p.wt1, NTOK, 12288, 2048}; EpiG1 E{p.proj, p.merge, p.b_merge, p.chk};
      pg8::gemm_phase<EpiG1>((LAS unsigned char*)shm, g, S, E); }
    GS(2);
#if DIAG
    if (multi) chk_sum(p.proj, (size_t)NTOK * 8192 * 2, p.chk + 3);
#endif
    PH(3) { phase3a(p, shm); if (multi) xcd_barrier(xb); phase3s(p, shm); }
    GS(3);
    PH(4) phase3b(p);
    GS(4);
    PH(5) { pg8::StaticOrder S; S.init(NTOK, 2048, (int)gridDim.x, (int)blockIdx.x); pg8::Gemm g{p.hy, p.wt2, NTOK, 2048, 2048}; EpiG2 E{p.merge, p.mix, (bf16_t*)p.tmp};
      pg8::gemm_phase<EpiG2>((LAS unsigned char*)shm, g, S, E); }
    GS(5);
    PH(6) { pg8::StaticOrder S; S.init(NTOK, 2048, (int)gridDim.x, (int)blockIdx.x); pg8::Gemm g{p.mix, p.wt3, NTOK, 2048, 2048}; EpiG3 E{p.outpre, p.ssq_o};
      pg8::gemm_phase<EpiG3>((LAS unsigned char*)shm, g, S, E); }
    GS(6);
#if DIAG
    float dscale = 1.0f;
    if (multi) {
        chk_sum(p.wt1, (size_t)(12288 + 2048 + 2048) * 2048 * 2, p.chk + 0);
        chk_sum(p.mod, (size_t)8 * 6144 * 4, p.chk + 1);
        chk_sum(p.o, (size_t)NTOK * 1024 * 2, p.chk + 5);
        chk_sum(p.ssq_h, (size_t)NTOK * 64 * 4, p.chk + 6);
        chk_sum(p.hy, (size_t)NTOK * 2048 * 2, p.chk + 7);
        chk_sum(p.mix, (size_t)NTOK * 2048 * 2, p.chk + 8);
        chk_sum(p.outpre, (size_t)NTOK * 2048 * 2, p.chk + 9);
        chk_sum(p.ssq_o, (size_t)NTOK * 32 * 4, p.chk + 10);
        chk_sum(p.merge, (size_t)NTOK * 4096 * 2, p.chk + 4);
        chk_sum(p.b_merge, (size_t)4096 * 4, p.chk + 13);
        gsync(grid);
        if (blockIdx.x == 0 && threadIdx.x == 0) {
            unsigned long long m = 0ull;
            if (p.chk[31] == 0x1234567887654321ull && p.chk[14] != p.chk[16 + 14]) m = 14ull;
            else if (p.chk[31] == 0x1234567887654321ull) { for (int k = 0; k < 11; ++k) if (p.chk[k] != p.chk[16 + k]) { m = (unsigned long long)(k + 1); break; } }
            for (int k = 0; k < 15; ++k) p.chk[16 + k] = p.chk[k];
            p.chk[31] = 0x1234567887654321ull; p.chk[32] = m;
        }
        gsync(grid);
        dscale = 1.0f + 0.2f * (float)__hip_atomic_load(p.chk + 32, __ATOMIC_RELAXED, __HIP_MEMORY_SCOPE_AGENT);
    }
    PH(7) phase6(p, dscale);
#else
    PH(7) phase6(p, 1.0f);
#endif
#undef PH
#undef GS
}

extern "C" void kernel_launch(void* const* d_in, const int* in_sizes, int n_in, void* d_out, int out_size, void* d_ws, size_t ws_size, hipStream_t stream) {
    (void)in_sizes; (void)n_in; (void)out_size;
    Params p{};
    p.x = (const float*)d_in[0]; p.c = (const float*)d_in[1]; p.w_ada = (const float*)d_in[2]; p.b_ada = (const float*)d_in[3]; p.g_pre = (const float*)d_in[4];
    p.w_in = (const float*)d_in[5]; p.lb_logits = (const float*)d_in[6]; p.g_head = (const float*)d_in[7]; p.conv_w = (const float*)d_in[8]; p.conv_b = (const float*)d_in[9];
    p.w_up_a = (const float*)d_in[10]; p.w_up_b = (const float*)d_in[11]; p.w_merge = (const float*)d_in[12]; p.b_merge = (const float*)d_in[13]; p.w_o = (const float*)d_in[14]; p.g_post = (const float*)d_in[15];
    p.out = (float*)d_out;
    unsigned char* ws = (unsigned char*)d_ws; size_t off = 0;
    auto take = [&](size_t bytes) { unsigned char* r = ws + off; off += (bytes + 255) & ~(size_t)255; return r; };
    p.wt1 = (bf16_t*)take((size_t)12288 * 2048 * 2);
    p.wt2 = (bf16_t*)take((size_t)2048 * 2048 * 2);
    p.wt3 = (bf16_t*)take((size_t)2048 * 2048 * 2);
    p.hy = (bf16_t*)take((size_t)NTOK * 2048 * 2);
    p.proj = (bf16_t*)take((size_t)NTOK * 8192 * 2);
    p.o = (bf16_t*)take((size_t)NTOK * 1024 * 2);
    p.mod = (float*)take((size_t)8 * 6144 * 4);
    p.ssq_h = (float*)take((size_t)NTOK * 64 * 4);
    p.ssq_o = (float*)take((size_t)NTOK * 32 * 4);
    p.bar = (unsigned*)take((size_t)XCD_BAR_WORDS * 4);
    p.img = take((size_t)2048 * IMG_BYTES);
    p.chk = (unsigned long long*)take(512);
    if (off > ws_size) return;
    p.merge = (bf16_t*)d_out;
    p.mix = p.proj;
    p.outpre = p.proj + (size_t)NTOK * 2048;
    p.tmp = (float*)(p.proj + (size_t)NTOK * 4096);
    static int grid_blocks = 0;
    if (!grid_blocks) {
        hipFuncSetAttribute((const void*)mega, hipFuncAttributeMaxDynamicSharedMemorySize, LDS_BYTES);
        int dev = 0, cus = 0, per_cu = 0;
        hipGetDevice(&dev);
        hipDeviceGetAttribute(&cus, hipDeviceAttributeMultiprocessorCount, dev);
        hipOccupancyMaxActiveBlocksPerMultiprocessor(&per_cu, mega, 512, LDS_BYTES);
        if (per_cu < 1) per_cu = 1;
        if (per_cu > 1) per_cu = 1;
        grid_blocks = cus * per_cu;
    }
#ifndef N_LAUNCH_SPLIT
#define N_LAUNCH_SPLIT 1
#endif
#if DIAG
    hipMemsetAsync(p.chk, 0, 128, stream);
#endif
    hipMemsetAsync(p.bar, 0, (size_t)XCD_BAR_WORDS * 4, stream);
    if (N_LAUNCH_SPLIT == 1) {
        p.ph_lo = 0; p.ph_hi = 8;
        void* args[] = {&p};
        hipError_t e = hipLaunchCooperativeKernel((void*)mega, dim3(grid_blocks), dim3(512), args, LDS_BYTES, stream);
        if (e != hipSuccess) fprintf(stderr, "cooperative launch failed: %s (grid %d)\n", hipGetErrorString(e), grid_blocks);
    } else {
        for (int ph = 0; ph < 8; ++ph) { p.ph_lo = ph; p.ph_hi = ph + 1; hipLaunchKernelGGL(mega, dim3(grid_blocks), dim3(512), LDS_BYTES, stream, p); }
    }
}
```

```cpp
#include <hip/hip_runtime.h>
#include <hip/hip_cooperative_groups.h>
#include <cstdio>
namespace cg = cooperative_groups;

#define LAS __attribute__((address_space(3)))
typedef unsigned short bf16_t;
typedef short bf16x8 __attribute__((ext_vector_type(8)));
typedef float f32x4 __attribute__((ext_vector_type(4)));
typedef float f32x2 __attribute__((ext_vector_type(2)));
typedef unsigned u32x4 __attribute__((ext_vector_type(4)));
typedef unsigned u32x2 __attribute__((ext_vector_type(2)));

constexpr int NTOK = 16384, DM = 2048, SEQ = 2048;
constexpr int LDS_BYTES = 131072 + 256;
#define EPSV 1e-6f

struct Params {
    const float *x, *c, *w_ada, *b_ada, *g_pre, *w_in, *lb_logits, *g_head, *conv_w, *conv_b, *w_up_a, *w_up_b, *w_merge, *b_merge, *w_o, *g_post;
    float* out;
    bf16_t *wt1, *wt2, *wt3, *hy, *proj, *merge, *o, *mix, *outpre;
    float *mod, *ssq_h, *ssq_o, *tmp;
    int ph_lo, ph_hi;
    unsigned long long* chk;
    unsigned* bar;
    unsigned char* img;
};

typedef __bf16 bf16x2_t __attribute__((ext_vector_type(2)));
__device__ __forceinline__ unsigned cvt_pk_bf16(float lo, float hi) { const f32x2 v = {lo, hi}; const bf16x2_t r = __builtin_convertvector(v, bf16x2_t); return __builtin_bit_cast(unsigned, r); }
__device__ __forceinline__ float bflo(unsigned w) { return __uint_as_float(w << 16); }
__device__ __forceinline__ float bfhi(unsigned w) { return __uint_as_float(w & 0xffff0000u); }
__device__ __forceinline__ float sigmoidf_(float x) { return __builtin_amdgcn_rcpf(1.0f + __expf(-x)); }
__device__ __forceinline__ float siluf_(float x) { return x * sigmoidf_(x); }

namespace pg8 {
constexpr int BM = 256, BK = 64, HALF = 128, HTB = HALF * BK * 2, STAGE_BYTES = 8 * HTB, NXCD = 8, WGM = 8;
__host__ __device__ __forceinline__ int lds_byte(int r, int c) { const int st = (r >> 4) * 2 + (c >> 5), rr = r & 15, cc = c & 31, ob = rr * 64 + cc * 2; return st * 1024 + (ob ^ (((ob >> 9) & 1) << 5)); }
__host__ __device__ __forceinline__ void stage_rc(int b, int& R, int& C) { const int st = b / 1024, sb = b % 1024, swz = sb ^ (((sb >> 9) & 1) << 5); R = (st >> 1) * 16 + swz / 64; C = (st & 1) * 32 + (swz % 64) / 2; }
__host__ __device__ __forceinline__ int perm32(int rho) { const int n = rho >> 4, i = rho & 15; return 8 * (i >> 2) + 4 * n + (i & 3); }
struct Unit { int pm, pn; };
struct Gemm { const bf16_t* A; const bf16_t* Bt; int M, N, K; };
struct StaticOrder {
    int nM, nN, nwg, G, c, rot;
    __device__ void init(int M, int N, int G_, int c_, int rot_ = 0) { nM = M / BM; nN = N / BM; nwg = nM * nN; G = G_; c = c_; rot = rot_; }
    __device__ bool next(int i, Unit& u) const {
        const long L = (long)i * G + c; if (L >= nwg) return false;
        int wgid = (int)L; { const int q = nwg / NXCD, r = nwg % NXCD, xcd = wgid % NXCD, off = wgid / NXCD; wgid = (xcd < r ? xcd * (q + 1) : r * (q + 1) + (xcd - r) * q) + off; }
        const int nig = WGM * nN, gid = wgid / nig, fm = gid * WGM, gsz = (nM - fm) < WGM ? (nM - fm) : WGM;
        u.pm = fm + ((wgid % nig) % gsz); u.pn = ((wgid % nig) / gsz + rot) % nN; return true;
    }
};

template <class Epi>
__device__ __forceinline__ void gemm_phase(LAS unsigned char* lds, const Gemm g, const StaticOrder& S, const Epi& E) {
    const int tid = threadIdx.x, wid = __builtin_amdgcn_readfirstlane(tid >> 6), lane = tid & 63, wr = wid >> 2, wc = wid & 3, fr = lane & 15, fq = lane >> 4;
    constexpr int KS = Epi::KSPLIT; const int K = g.K, nt = K / BK / KS; const size_t khstep = (size_t)(K / KS) * 2;
    unsigned voffA[2], voffB[2];
#pragma unroll
    for (int i = 0; i < 2; ++i) { int R, C; stage_rc(tid * 16 + i * 8192, R, C); const int Rb = Epi::PERM ? ((R & ~31) + perm32(R & 31)) : R;
        voffA[i] = (unsigned)(R * K + C) * 2u; voffB[i] = (unsigned)(Rb * K + C) * 2u; }
    const size_t kstep = (size_t)(BK * 2);
    const size_t hstep = (size_t)HALF * K * 2;
    const size_t tstep = 2 * hstep;
    const unsigned ldsw = (unsigned)wid * 1024u;
    const int aoff = lds_byte(wr * 64 + fr, fq * 8), boff = lds_byte(wc * 32 + fr, fq * 8);
#define PG8_SA(b, h) (((b) * 2 + (h)) * HTB)
#define PG8_SB(b, h) ((4 + (b) * 2 + (h)) * HTB)
#define PG8_STAGE(bufoff, gbase, voff) do { _Pragma("unroll") for (int _i = 0; _i < 2; ++_i) \
        __builtin_amdgcn_global_load_lds((const unsigned*)((const char*)(gbase) + (voff)[_i]), (LAS unsigned*)(lds + (bufoff) + ldsw + _i * 8192), 16, 0, 0); } while (0)
#define PG8_LDA(dst, b, h) do { _Pragma("unroll") for (int m = 0; m < 4; ++m) _Pragma("unroll") for (int k = 0; k < 2; ++k) dst[m][k] = *(const LAS bf16x8*)(lds + PG8_SA(b, h) + aoff + m * 2048 + k * 1024); } while (0)
#define PG8_LDB(dst, b, h) do { _Pragma("unroll") for (int n = 0; n < 2; ++n) _Pragma("unroll") for (int k = 0; k < 2; ++k) dst[n][k] = *(const LAS bf16x8*)(lds + PG8_SB(b, h) + boff + n * 2048 + k * 1024); } while (0)
#define PG8_MMA(ai, bj, At, Bt) do { __builtin_amdgcn_s_setprio(1); _Pragma("unroll") for (int m = 0; m < 4; ++m) _Pragma("unroll") for (int n = 0; n < 2; ++n) _Pragma("unroll") for (int k = 0; k < 2; ++k) \
        acc[ai][bj][m][n] = __builtin_amdgcn_mfma_f32_16x16x32_bf16(Bt[n][k], At[m][k], acc[ai][bj][m][n], 0, 0, 0); __builtin_amdgcn_s_setprio(0); } while (0)
#define PG8_WAIT_V(n) asm volatile("s_waitcnt vmcnt(" #n ")" ::: "memory")
#define PG8_WAIT_L(n) asm volatile("s_waitcnt lgkmcnt(" #n ")" ::: "memory")
#define PG8_BAR __builtin_amdgcn_s_barrier()
#define PG8_SCHED __builtin_amdgcn_sched_barrier(0)
    Unit cur, nxt; int ui = 0;
    if (!S.next(0, cur)) return;
    f32x4 acc[2][2][4][2];
#pragma unroll
    for (int a = 0; a < 2; ++a)
#pragma unroll
        for (int b = 0; b < 2; ++b)
#pragma unroll
            for (int m = 0; m < 4; ++m)
#pragma unroll
                for (int n = 0; n < 2; ++n) acc[a][b][m][n] = (f32x4){0.f, 0.f, 0.f, 0.f};
    bf16x8 At[4][2], B0[2][2], B1[2][2];
    const char* cA = (const char*)g.A + (size_t)cur.pm * tstep; const char* cB = (const char*)g.Bt + (size_t)cur.pn * tstep;
    PG8_STAGE(PG8_SB(0, 0), cB, voffB); PG8_STAGE(PG8_SA(0, 0), cA, voffA); PG8_STAGE(PG8_SB(0, 1), cB + hstep, voffB); PG8_STAGE(PG8_SA(0, 1), cA + hstep, voffA);
    if (wr == 1) PG8_BAR;
    PG8_WAIT_V(4); PG8_BAR;
    PG8_STAGE(PG8_SB(1, 0), cB + kstep, voffB); PG8_STAGE(PG8_SA(1, 0), cA + kstep, voffA); PG8_STAGE(PG8_SB(1, 1), cB + hstep + kstep, voffB);
    PG8_WAIT_V(6); PG8_BAR;
    auto kloop = [&](const char* cA, const char* cB, const char* nA, const char* nB) __attribute__((always_inline)) {
        for (int t = 0; t < nt; t += 2) {
            const bool last = (t == nt - 2);
            const char* a1 = cA + (size_t)(t + 1) * kstep;
            const char* a2 = last ? nA : cA + (size_t)(t + 2) * kstep; const char* b2 = last ? nB : cB + (size_t)(t + 2) * kstep;
            const char* a3 = a2 + kstep; const char* b3 = b2 + kstep;
            PG8_LDB(B0, 0, 0); PG8_SCHED; PG8_LDA(At, 0, 0); PG8_STAGE(PG8_SA(1, 1), a1 + hstep, voffA);
            PG8_WAIT_L(8); PG8_BAR; PG8_WAIT_L(0); PG8_MMA(0, 0, At, B0); PG8_BAR; PG8_SCHED;
            PG8_LDB(B1, 0, 1); PG8_STAGE(PG8_SB(0, 0), b2, voffB);
            PG8_BAR; PG8_WAIT_L(0); PG8_MMA(0, 1, At, B1); PG8_BAR;
            PG8_LDA(At, 0, 1); PG8_STAGE(PG8_SA(0, 0), a2, voffA);
            PG8_BAR; PG8_WAIT_L(0); PG8_MMA(1, 0, At, B0); PG8_BAR; PG8_SCHED;
            PG8_STAGE(PG8_SB(0, 1), b2 + hstep, voffB);
            PG8_WAIT_V(6); PG8_BAR; PG8_MMA(1, 1, At, B1); PG8_BAR;
            PG8_LDB(B0, 1, 0); PG8_SCHED; PG8_LDA(At, 1, 0); PG8_STAGE(PG8_SA(0, 1), a2 + hstep, voffA);
            PG8_WAIT_L(8); PG8_BAR; PG8_WAIT_L(0); PG8_MMA(0, 0, At, B0); PG8_BAR; PG8_SCHED;
            PG8_LDB(B1, 1, 1); PG8_STAGE(PG8_SB(1, 0), b3, voffB);
            PG8_BAR; PG8_WAIT_L(0); PG8_MMA(0, 1, At, B1); PG8_BAR;
            PG8_LDA(At, 1, 1); PG8_STAGE(PG8_SA(1, 0), a3, voffA);
            PG8_BAR; PG8_WAIT_L(0); PG8_MMA(1, 0, At, B0); PG8_BAR; PG8_SCHED;
            PG8_STAGE(PG8_SB(1, 1), b3 + hstep, voffB);
            PG8_WAIT_V(6); PG8_BAR; PG8_MMA(1, 1, At, B1); PG8_BAR;
        }
    };
    for (;;) {
        const int kh = (KS == 1) ? 0 : (ui % KS), nkh = (KS == 1) ? 0 : ((ui + 1) % KS);
        bool has_next = true; nxt = cur;
        if (nkh == 0) has_next = S.next((ui + 1) / KS, nxt);
        const char* nA = has_next ? (const char*)g.A + (size_t)nxt.pm * tstep + nkh * khstep : cA; const char* nB = has_next ? (const char*)g.Bt + (size_t)nxt.pn * tstep + nkh * khstep : cB;
        kloop(cA, cB, nA, nB);
        E(acc, cur, kh, wr, wc, fr, fq);
        if (!has_next) break;
#pragma unroll
        for (int a = 0; a < 2; ++a)
#pragma unroll
            for (int b = 0; b < 2; ++b)
#pragma unroll
                for (int m = 0; m < 4; ++m)
#pragma unroll
                    for (int n = 0; n < 2; ++n) acc[a][b][m][n] = (f32x4){0.f, 0.f, 0.f, 0.f};
        cur = nxt; cA = nA; cB = nB; ++ui;
    }
    PG8_WAIT_V(0);
    if (wr == 0) PG8_BAR;
    PG8_BAR;
#undef PG8_SA
#undef PG8_SB
#undef PG8_STAGE
#undef PG8_LDA
#undef PG8_LDB
#undef PG8_MMA
#undef PG8_WAIT_V
#undef PG8_WAIT_L
#undef PG8_BAR
#undef PG8_SCHED
}
}
using pg8::Unit;

struct EpiG1 {
    static constexpr bool PERM = true; static constexpr int KSPLIT = 1;
    bf16_t* proj; bf16_t* merge; const float* b_merge; unsigned long long* chk;
    __device__ __forceinline__ void operator()(const f32x4 (&acc)[2][2][4][2], const Unit& u, int kh, int wr, int wc, int fr, int fq) const {
        const int row0 = u.pm * 256 + wr * 64 + fr;
        if (u.pn < 32) {
            const int col0 = u.pn * 256 + wc * 32 + 8 * fq;
#pragma unroll
            for (int ai = 0; ai < 2; ++ai)
#pragma unroll
                for (int m = 0; m < 4; ++m) { bf16_t* rowp = proj + (size_t)(row0 + ai * 128 + m * 16) * 8192 + col0;
#pragma unroll
                    for (int bj = 0; bj < 2; ++bj) { const f32x4 v0 = acc[ai][bj][m][0], v1 = acc[ai][bj][m][1];
                        u32x4 w; w.x = cvt_pk_bf16(v0[0], v0[1]); w.y = cvt_pk_bf16(v0[2], v0[3]); w.z = cvt_pk_bf16(v1[0], v1[1]); w.w = cvt_pk_bf16(v1[2], v1[3]);
                        __builtin_nontemporal_store(w, (u32x4*)(rowp + bj * 128)); } }
        } else {
            const int col0 = (u.pn - 32) * 256 + wc * 32 + 8 * fq;
            bf16_t* tb = merge + ((size_t)(u.pm * 16 + (u.pn - 32)) * 65536) + (size_t)(wr * 4 + wc) * 8192 + (size_t)(fq * 16 + fr) * 8;
            f32x4 bv[2][2];
#pragma unroll
            for (int bj = 0; bj < 2; ++bj)
#pragma unroll
                for (int n = 0; n < 2; ++n) bv[bj][n] = *(const f32x4*)(b_merge + col0 + bj * 128 + 4 * n);
#pragma unroll
            for (int g = 0; g < 4; ++g) {
#pragma unroll
                for (int j = 0; j < 4; ++j) { const int ai = g >> 1, m = (g & 1) * 2 + (j >> 1), bj = j & 1;
                    f32x4 v0 = acc[ai][bj][m][0] + bv[bj][0], v1 = acc[ai][bj][m][1] + bv[bj][1];
#pragma unroll
                    for (int e = 0; e < 4; ++e) { v0[e] = sigmoidf_(v0[e]); v1[e] = sigmoidf_(v1[e]); }
                    u32x4 w; w.x = cvt_pk_bf16(v0[0], v0[1]); w.y = cvt_pk_bf16(v0[2], v0[3]); w.z = cvt_pk_bf16(v1[0], v1[1]); w.w = cvt_pk_bf16(v1[2], v1[3]);
                    __builtin_nontemporal_store(w, (u32x4*)(tb + j * 512)); }
                tb += 2048; asm volatile("" : "+v"(tb)); }
        }
    }
};
struct EpiG2 {
    static constexpr bool PERM = true; static constexpr int KSPLIT = 2;
    const bf16_t* merge; bf16_t* mix; bf16_t* park;
    __device__ __forceinline__ void operator()(const f32x4 (&acc)[2][2][4][2], const Unit& u, int kh, int wr, int wc, int fr, int fq) const {
        const int row0 = u.pm * 256 + wr * 64 + fr, col0 = u.pn * 256 + wc * 32 + 8 * fq;
        const size_t lo = (size_t)(wr * 4 + wc) * 8192 + (size_t)(fq * 16 + fr) * 8;
        bf16_t* pk = park + (size_t)blockIdx.x * 65536 + lo;
        if (kh == 0) {
            const bf16_t* ta = merge + ((size_t)(u.pm * 16 + u.pn) * 65536) + lo;
#pragma unroll
            for (int g = 0; g < 4; ++g) {
                u32x4 a[4];
#pragma unroll
                for (int j = 0; j < 4; ++j) a[j] = __builtin_nontemporal_load((const u32x4*)(ta + j * 512));
#pragma unroll
                for (int j = 0; j < 4; ++j) { const int ai = g >> 1, m = (g & 1) * 2 + (j >> 1), bj = j & 1; const u32x4 aa = a[j];
                    const f32x4 v0 = acc[ai][bj][m][0], v1 = acc[ai][bj][m][1];
                    u32x4 w; w.x = cvt_pk_bf16(v0[0] * bflo(aa.x), v0[1] * bfhi(aa.x)); w.y = cvt_pk_bf16(v0[2] * bflo(aa.y), v0[3] * bfhi(aa.y));
                    w.z = cvt_pk_bf16(v1[0] * bflo(aa.z), v1[1] * bfhi(aa.z)); w.w = cvt_pk_bf16(v1[2] * bflo(aa.w), v1[3] * bfhi(aa.w));
                    *(u32x4*)(pk + j * 512) = w; }
                ta += 2048; pk += 2048; asm volatile("" : "+v"(ta), "+v"(pk)); }
        } else {
            const bf16_t* tbm = merge + ((size_t)(u.pm * 16 + 8 + u.pn) * 65536) + lo;
            bf16_t* mp = mix + (size_t)row0 * 2048 + col0;
#pragma unroll
            for (int g = 0; g < 8; ++g) {
                u32x4 b[2], t[2];
#pragma unroll
                for (int j = 0; j < 2; ++j) { b[j] = __builtin_nontemporal_load((const u32x4*)(tbm + ((g & 1) * 2 + j) * 512)); t[j] = __builtin_nontemporal_load((const u32x4*)(pk + ((g & 1) * 2 + j) * 512)); }
#pragma unroll
                for (int j = 0; j < 2; ++j) { const int ai = g >> 2, m = g & 3, bj = j; const u32x4 bb = b[j], tt = t[j];
                    const f32x4 v0 = acc[ai][bj][m][0], v1 = acc[ai][bj][m][1];
                    u32x4 w; w.x = cvt_pk_bf16(bflo(tt.x) + v0[0] * bflo(bb.x), bfhi(tt.x) + v0[1] * bfhi(bb.x)); w.y = cvt_pk_bf16(bflo(tt.y) + v0[2] * bflo(bb.y), bfhi(tt.y) + v0[3] * bfhi(bb.y));
                    w.z = cvt_pk_bf16(bflo(tt.z) + v1[0] * bflo(bb.z), bfhi(tt.z) + v1[1] * bfhi(bb.z)); w.w = cvt_pk_bf16(bflo(tt.w) + v1[2] * bflo(bb.w), bfhi(tt.w) + v1[3] * bfhi(bb.w));
                    *(u32x4*)(mp + bj * 128) = w; }
                if (g & 1) { tbm += 2048; pk += 2048; }
                mp += (g == 3) ? (size_t)(128 - 48) * 2048 : (size_t)16 * 2048;
                asm volatile("" : "+v"(tbm), "+v"(pk), "+v"(mp)); }
        }
    }
};
struct EpiG3 {
    static constexpr bool PERM = true; static constexpr int KSPLIT = 1;
    bf16_t* outpre; float* ssq;
    __device__ __forceinline__ void operator()(const f32x4 (&acc)[2][2][4][2], const Unit& u, int kh, int wr, int wc, int fr, int fq) const {
        const int row0 = u.pm * 256 + wr * 64 + fr, col0 = u.pn * 256 + wc * 32 + 8 * fq;
#pragma unroll
        for (int ai = 0; ai < 2; ++ai)
#pragma unroll
            for (int m = 0; m < 4; ++m) { const size_t r = (size_t)(row0 + ai * 128 + m * 16); float s = 0.f;
#pragma unroll
                for (int bj = 0; bj < 2; ++bj) { const f32x4 v0 = acc[ai][bj][m][0], v1 = acc[ai][bj][m][1];
                    s += v0[0] * v0[0] + v0[1] * v0[1] + v0[2] * v0[2] + v0[3] * v0[3] + v1[0] * v1[0] + v1[1] * v1[1] + v1[2] * v1[2] + v1[3] * v1[3];
                    u32x4 w; w.x = cvt_pk_bf16(v0[0], v0[1]); w.y = cvt_pk_bf16(v0[2], v0[3]); w.z = cvt_pk_bf16(v1[0], v1[1]); w.w = cvt_pk_bf16(v1[2], v1[3]);
                    *(u32x4*)(outpre + r * 2048 + col0 + bj * 128) = w; }
                s += __shfl_xor(s, 16); s += __shfl_xor(s, 32);
                if (fq == 0) ssq[r * 32 + u.pn * 4 + wc] = s; }
    }
};

__device__ __forceinline__ void gemv_item(const Params& p, int item, unsigned char* lds) {
    const int tid = threadIdx.x;
    float* cact = (float*)lds;
    float* red = (float*)(lds + 65536);
    for (int i = tid; i < 8 * 2048; i += 512) cact[(i & 2047) * 8 + (i >> 11)] = siluf_(p.c[i]);
    __syncthreads();
    const int col = tid & 31, dg = tid >> 5;
    const float* wp = p.w_ada + (size_t)dg * 6144 + item * 32 + col;
    f32x4 a0 = {0.f, 0.f, 0.f, 0.f}, a1 = {0.f, 0.f, 0.f, 0.f};
#pragma unroll 16
    for (int i = 0; i < 128; ++i) { const float w = __builtin_nontemporal_load(wp + (size_t)i * 16 * 6144); const int d = dg + 16 * i;
        const f32x4 c0 = *(const f32x4*)(cact + d * 8), c1 = *(const f32x4*)(cact + d * 8 + 4);
        a0 += c0 * w; a1 += c1 * w; }
    red[(dg * 8 + 0) * 32 + col] = a0[0]; red[(dg * 8 + 1) * 32 + col] = a0[1]; red[(dg * 8 + 2) * 32 + col] = a0[2]; red[(dg * 8 + 3) * 32 + col] = a0[3];
    red[(dg * 8 + 4) * 32 + col] = a1[0]; red[(dg * 8 + 5) * 32 + col] = a1[1]; red[(dg * 8 + 6) * 32 + col] = a1[2]; red[(dg * 8 + 7) * 32 + col] = a1[3];
    __syncthreads();
    if (tid < 256) { const int b = tid >> 5, c = tid & 31; float s = 0.f;
#pragma unroll
        for (int g = 0; g < 16; ++g) s += red[(g * 8 + b) * 32 + c];
        p.mod[b * 6144 + item * 32 + c] = s + p.b_ada[item * 32 + c]; }
    __syncthreads();
}
__device__ __forceinline__ void transpose_tile(const float* src, int N, int k0, int n0, bf16_t* dst, int dst_ld, int koff) {
    const int lane = threadIdx.x & 63, wid = threadIdx.x >> 6;
    const float* sp = src + (size_t)(k0 + wid * 32) * N + n0 + lane;
    float v[32];
#pragma unroll
    for (int i = 0; i < 32; ++i) v[i] = __builtin_nontemporal_load(sp + (size_t)i * N);
    bf16_t* dp = dst + (size_t)(n0 + lane) * dst_ld + koff + k0 + wid * 32;
#pragma unroll
    for (int c = 0; c < 4; ++c) { u32x4 w; w.x = cvt_pk_bf16(v[c * 8 + 0], v[c * 8 + 1]); w.y = cvt_pk_bf16(v[c * 8 + 2], v[c * 8 + 3]); w.z = cvt_pk_bf16(v[c * 8 + 4], v[c * 8 + 5]); w.w = cvt_pk_bf16(v[c * 8 + 6], v[c * 8 + 7]);
        *(u32x4*)(dp + c * 8) = w; }
}
__device__ __forceinline__ void transpose_item(const Params& p, int id) {
    if (id < 1024) { transpose_tile(p.w_in, 8192, (id >> 7) * 256, (id & 127) * 64, p.wt1, 2048, 0); }
    else if (id < 1536) { id -= 1024; transpose_tile(p.w_merge, 4096, (id >> 6) * 256, (id & 63) * 64, p.wt1 + (size_t)8192 * 2048, 2048, 0); }
    else if (id < 1664) { id -= 1536; transpose_tile(p.w_up_a, 2048, (id >> 5) * 256, (id & 31) * 64, p.wt2, 2048, 0); }
    else if (id < 1792) { id -= 1664; transpose_tile(p.w_up_b, 2048, (id >> 5) * 256, (id & 31) * 64, p.wt2, 2048, 1024); }
    else { id -= 1792; transpose_tile(p.w_o, 2048, (id >> 5) * 256, (id & 31) * 64, p.wt3, 2048, 0); }
}
__device__ __forceinline__ void phase0(const Params& p, unsigned char* lds) {
    constexpr int NG = 192, NTL = 2048;
    if (gridDim.x == 256) {
        const int c = blockIdx.x;
        if (c < NG) { gemv_item(p, c, lds); for (int i = 0; i < 7; ++i) transpose_item(p, c * 7 + i); }
        else { for (int i = 0; i < 11; ++i) transpose_item(p, NG * 7 + (c - NG) * 11 + i); }
    } else {
        for (int item = blockIdx.x; item < NG + NTL; item += gridDim.x) { if (item < NG) gemv_item(p, item, lds); else transpose_item(p, item - NG); }
    }
}

__device__ __forceinline__ void phase1(const Params& p) {
    const int tid = threadIdx.x, wid = tid >> 6, lane = tid & 63;
    const int gw = blockIdx.x * 8 + wid, nw = gridDim.x * 8;
    for (int r0 = gw * 8; r0 < NTOK; r0 += nw * 8) {
        const int b = r0 >> 11; const float* md = p.mod + b * 6144;
        f32x4 gs[8], sh[8];
#pragma unroll
        for (int i = 0; i < 8; ++i) { const int c = i * 256 + lane * 4; const f32x4 g = *(const f32x4*)(p.g_pre + c), sc = *(const f32x4*)(md + 2048 + c);
            sh[i] = *(const f32x4*)(md + c); gs[i] = g * (1.0f + sc); }
        for (int j = 0; j < 8; ++j) { const size_t row = (size_t)(r0 + j); f32x4 xv[8]; float ss = 0.f;
#pragma unroll
            for (int i = 0; i < 8; ++i) { xv[i] = __builtin_nontemporal_load((const f32x4*)(p.x + row * DM + i * 256 + lane * 4)); ss += xv[i][0] * xv[i][0] + xv[i][1] * xv[i][1] + xv[i][2] * xv[i][2] + xv[i][3] * xv[i][3]; }
#pragma unroll
            for (int o = 1; o < 64; o <<= 1) ss += __shfl_xor(ss, o);
            const float rstd = rsqrtf(ss * (1.0f / DM) + EPSV);
#pragma unroll
            for (int i = 0; i < 8; ++i) { const f32x4 hv = xv[i] * rstd * gs[i] + sh[i];
                u32x2 w; w.x = cvt_pk_bf16(hv[0], hv[1]); w.y = cvt_pk_bf16(hv[2], hv[3]);
                *(u32x2*)(p.hy + row * DM + i * 256 + lane * 4) = w; } }
    }
}

constexpr int IMG_BYTES = 41472;
__device__ __forceinline__ void phase3a(const Params& p, unsigned char* lds) {
    const int tid = threadIdx.x, wid = __builtin_amdgcn_readfirstlane(tid >> 6), lane = tid & 63, l15 = lane & 15, q4 = lane >> 4;
    constexpr int RSD = 272;
    unsigned char* QR = lds;
    unsigned char* KR = QR + 17408;
    float* SEG = (float*)(KR + 17408);
    const int d0 = 2 * lane;
    auto map_ch = [&](int ch0) { return (gridDim.x == 256) ? ((ch0 & 7) * 256 + (ch0 >> 8) * 32 + ((ch0 >> 3) & 31)) : ch0; };
    auto load_in = [&](int ch, unsigned (&ff)[8], unsigned (&qq)[8]) __attribute__((always_inline)) {
        const int b = ch >> 8, n = (ch >> 3) & 31, h = ch & 7;
        const bf16_t* base = p.proj + (size_t)(b * SEQ + n * 64 + wid * 8) * 8192 + h * 128 + d0;
#pragma unroll
        for (int i = 0; i < 8; ++i) { ff[i] = __builtin_nontemporal_load((const unsigned*)(base + 1024 + (size_t)i * 8192)); qq[i] = __builtin_nontemporal_load((const unsigned*)(base + (size_t)i * 8192)); }
    };
    auto item_body = [&](int ch, const unsigned (&ff)[8], const unsigned (&qq)[8]) __attribute__((always_inline)) {
        const int h = ch & 7;
        float lb0, lb1;
        { const float l00 = p.lb_logits[h * 128 + d0], l01 = p.lb_logits[h * 128 + d0 + 1], l10 = p.lb_logits[1024 + h * 128 + d0], l11 = p.lb_logits[1024 + h * 128 + d0 + 1];
          lb0 = 1.0f / (1.0f + expf(l10 - l00)); lb1 = 1.0f / (1.0f + expf(l11 - l01)); }
        const float om0 = 1.0f - lb0, om1 = 1.0f - lb1;
        unsigned char* img = p.img + (size_t)ch * IMG_BYTES;
        float cp[8][2], kk[8][2], qv[8][2];
        float run0 = 1.f, run1 = 1.f;
#pragma unroll
        for (int i = 0; i < 8; ++i) {
            const float s0 = sigmoidf_(bflo(ff[i])), s1 = sigmoidf_(bfhi(ff[i]));
            const float f0 = lb0 + om0 * s0, f1 = lb1 + om1 * s1;
            run0 *= f0; run1 *= f1; cp[i][0] = run0; cp[i][1] = run1;
            kk[i][0] = 1.0f - f0; kk[i][1] = 1.0f - f1;
            qv[i][0] = bflo(qq[i]); qv[i][1] = bfhi(qq[i]); }
        *(f32x2*)(SEG + wid * 128 + d0) = (f32x2){run0, run1};
        __syncthreads();
        float pre0 = 1.f, pre1 = 1.f, mid0 = 1.f, mid1 = 1.f, las0 = 1.f, las1 = 1.f;
#pragma unroll
        for (int w = 0; w < 8; ++w) { const f32x2 sg = *(const f32x2*)(SEG + w * 128 + d0);
            if (w < wid) { pre0 *= sg.x; pre1 *= sg.y; } if (w < 4) { mid0 *= sg.x; mid1 *= sg.y; } las0 *= sg.x; las1 *= sg.y; }
        const float rmid0 = __builtin_amdgcn_rcpf(mid0), rmid1 = __builtin_amdgcn_rcpf(mid1);
        unsigned klt0[4], klt1[4];
#pragma unroll
        for (int i = 0; i < 8; i += 2) {
            float kl[2][2];
#pragma unroll
            for (int ii = 0; ii < 2; ++ii) {
                const float P0 = fmaxf(pre0 * cp[i + ii][0], 1e-30f), P1 = fmaxf(pre1 * cp[i + ii][1], 1e-30f);
                const float rP0 = __builtin_amdgcn_rcpf(P0), rP1 = __builtin_amdgcn_rcpf(P1);
                const float qb0 = qv[i + ii][0] * P0, qb1 = qv[i + ii][1] * P1;
                const float kp0 = kk[i + ii][0] * rP0, kp1 = kk[i + ii][1] * rP1;
                kl[ii][0] = kp0 * las0; kl[ii][1] = kp1 * las1;
                const int t = wid * 8 + i + ii;
                *(unsigned*)(QR + t * RSD + d0 * 2) = cvt_pk_bf16(qb0 * rmid0, qb1 * rmid1);
                *(unsigned*)(KR + t * RSD + d0 * 2) = cvt_pk_bf16(kp0 * mid0, kp1 * mid1);
                *(unsigned*)(img + t * 256 + d0 * 2) = cvt_pk_bf16(qb0, qb1);
            }
            klt0[i >> 1] = cvt_pk_bf16(kl[0][0], kl[1][0]); klt1[i >> 1] = cvt_pk_bf16(kl[0][1], kl[1][1]);
        }
        *(u32x4*)(img + 16384 + d0 * 128 + wid * 16) = (u32x4){klt0[0], klt0[1], klt0[2], klt0[3]};
        *(u32x4*)(img + 16384 + (d0 + 1) * 128 + wid * 16) = (u32x4){klt1[0], klt1[1], klt1[2], klt1[3]};
        if (wid == 0) *(f32x2*)(img + 40960 + d0 * 4) = (f32x2){las0, las1};
        __syncthreads();
        const int tt = wid >> 1;
#pragma unroll
        for (int s2 = 0; s2 < 2; ++s2) { const int st = (wid & 1) * 2 + s2;
            f32x4 pacc = (f32x4){0.f, 0.f, 0.f, 0.f};
            if (st <= tt) {
#pragma unroll
                for (int ks = 0; ks < 4; ++ks) { const bf16x8 a = *(const bf16x8*)(KR + (st * 16 + l15) * RSD + (ks * 32 + q4 * 8) * 2), bb = *(const bf16x8*)(QR + (tt * 16 + l15) * RSD + (ks * 32 + q4 * 8) * 2);
                    pacc = __builtin_amdgcn_mfma_f32_16x16x32_bf16(a, bb, pacc, 0, 0, 0); } }
            const int t = tt * 16 + l15, sb = st * 16 + q4 * 4;
            const float v0 = (sb + 0 <= t) ? pacc[0] : 0.f, v1 = (sb + 1 <= t) ? pacc[1] : 0.f, v2 = (sb + 2 <= t) ? pacc[2] : 0.f, v3 = (sb + 3 <= t) ? pacc[3] : 0.f;
            u32x2 w; w.x = cvt_pk_bf16(v0, v1); w.y = cvt_pk_bf16(v2, v3);
            *(u32x2*)(img + 32768 + t * 128 + sb * 2) = w; }
    };
    if (gridDim.x == 256) {
        unsigned fa[8], qa[8], fb[8], qb[8];
        load_in(map_ch(blockIdx.x), fa, qa);
#pragma unroll
        for (int k = 0; k < 8; k += 2) {
            load_in(map_ch(blockIdx.x + (k + 1) * 256), fb, qb);
            item_body(map_ch(blockIdx.x + k * 256), fa, qa);
            if (k + 2 < 8) load_in(map_ch(blockIdx.x + (k + 2) * 256), fa, qa);
            item_body(map_ch(blockIdx.x + (k + 1) * 256), fb, qb);
        }
    } else {
        for (int ch0 = blockIdx.x; ch0 < 2048; ch0 += gridDim.x) { unsigned fa[8], qa[8]; load_in(ch0, fa, qa); item_body(ch0, fa, qa); }
    }
}
__device__ __forceinline__ void phase3s(const Params& p, unsigned char* lds) {
    const int tid = threadIdx.x, wid = __builtin_amdgcn_readfirstlane(tid >> 6), lane = tid & 63, l15 = lane & 15, q4 = lane >> 4;
    constexpr int RSD = 272, RSS = 144, IMGL = 49664;
    unsigned char* ST = lds + 2 * IMGL;
    for (int item0 = blockIdx.x; item0 < 256; item0 += gridDim.x) {
        const int item = (gridDim.x == 256) ? ((((item0 & 7) * 8 + (item0 >> 5)) << 2) | ((item0 >> 3) & 3)) : item0;
        const int b = item >> 5, h = (item >> 2) & 7, vs = item & 3;
        const bf16_t* vp = p.proj + (size_t)(b * SEQ) * 8192 + 2048 + h * 128 + vs * 32 + (tid & 7) * 4 + (size_t)(tid >> 3) * 8192;
        const unsigned char* img0 = p.img + (size_t)((b * 32) * 8 + h) * IMG_BYTES;
        for (int i = tid; i < 2 * 8704 / 4; i += 512) ((unsigned*)ST)[i] = 0u;
        f32x4 sacc[4];
#pragma unroll
        for (int i = 0; i < 4; ++i) sacc[i] = (f32x4){0.f, 0.f, 0.f, 0.f};
        u32x4 rq0[3], rq1[3], rk0[3], rk1[3], rp[3]; f32x4 rdec0[3], rdec1[3]; u32x2 rv[3];
        const int wd = (wid & 3) * 2;
#define P3S_LOAD(S, nn) do { const unsigned char* im = img0 + (size_t)(nn) * 8 * IMG_BYTES; \
            rq0[S] = *(const u32x4*)(im + tid * 16); rq1[S] = *(const u32x4*)(im + 8192 + tid * 16); \
            rk0[S] = *(const u32x4*)(im + 16384 + tid * 16); rk1[S] = *(const u32x4*)(im + 24576 + tid * 16); \
            rp[S] = *(const u32x4*)(im + 32768 + tid * 16); \
            rdec0[S] = *(const f32x4*)(im + 40960 + (16 * wd + q4 * 4) * 4); rdec1[S] = *(const f32x4*)(im + 40960 + (16 * wd + 16 + q4 * 4) * 4); \
            rv[S] = __builtin_nontemporal_load((const u32x2*)(vp + (size_t)(nn) * 64 * 8192)); } while (0)
#define P3S_PUT(S, nn) do { unsigned char* B_ = lds + ((nn) & 1) * IMGL; \
            u32x4 q0 = rq0[S], q1 = rq1[S], k0 = rk0[S], k1 = rk1[S], pm = rp[S]; unsigned vx = rv[S].x, vy = rv[S].y; \
            asm volatile("" : "+v"(q0), "+v"(q1), "+v"(k0), "+v"(k1), "+v"(pm), "+v"(vx), "+v"(vy)); \
            const int pa = tid, pb = tid + 512; \
            *(u32x4*)(B_ + (pa >> 4) * RSD + (pa & 15) * 16) = q0; *(u32x4*)(B_ + (pb >> 4) * RSD + (pb & 15) * 16) = q1; \
            *(u32x4*)(B_ + 17408 + (pa >> 3) * RSS + (pa & 7) * 16) = k0; *(u32x4*)(B_ + 17408 + (pb >> 3) * RSS + (pb & 7) * 16) = k1; \
            *(u32x4*)(B_ + 35840 + (pa >> 3) * RSS + (pa & 7) * 16) = pm; \
            const int t = tid >> 3, v4 = (tid & 7) * 4; \
            *(bf16_t*)(B_ + 45056 + (v4 + 0) * RSS + t * 2) = (bf16_t)(vx & 0xffff); *(bf16_t*)(B_ + 45056 + (v4 + 1) * RSS + t * 2) = (bf16_t)(vx >> 16); \
            *(bf16_t*)(B_ + 45056 + (v4 + 2) * RSS + t * 2) = (bf16_t)(vy & 0xffff); *(bf16_t*)(B_ + 45056 + (v4 + 3) * RSS + t * 2) = (bf16_t)(vy >> 16); } while (0)
#define P3S_STEP(S1, n) do { \
            f32x4 dcur0 = rdec0[(n) % 3], dcur1 = rdec1[(n) % 3]; asm volatile("" : "+v"(dcur0), "+v"(dcur1)); \
            if ((n) + 1 < 32) P3S_PUT(S1, (n) + 1);                       \
            asm volatile("" ::: "memory"); \
            if ((n) + 3 < 32) P3S_LOAD((n) % 3, (n) + 3);                \
            asm volatile("" ::: "memory"); \
            const unsigned char* B_ = lds + ((n) & 1) * IMGL; const unsigned char* QB = B_; const unsigned char* KLT = B_ + 17408; const unsigned char* PM = B_ + 35840; const unsigned char* VT = B_ + 45056; \
            const unsigned char* STc = ST + ((n) & 1) * 8704; unsigned char* STn = ST + (((n) + 1) & 1) * 8704; \
            if (wid < 4) { const int tt = wid; \
                f32x4 oa0 = (f32x4){0.f, 0.f, 0.f, 0.f}, oa1 = (f32x4){0.f, 0.f, 0.f, 0.f}; \
                _Pragma("unroll") for (int ks = 0; ks < 4; ++ks) { const bf16x8 bb = *(const bf16x8*)(QB + (tt * 16 + l15) * RSD + (ks * 32 + q4 * 8) * 2); \
                    const bf16x8 a0 = *(const bf16x8*)(STc + (l15) * RSD + (ks * 32 + q4 * 8) * 2), a1 = *(const bf16x8*)(STc + (16 + l15) * RSD + (ks * 32 + q4 * 8) * 2); \
                    oa0 = __builtin_amdgcn_mfma_f32_16x16x32_bf16(a0, bb, oa0, 0, 0, 0); oa1 = __builtin_amdgcn_mfma_f32_16x16x32_bf16(a1, bb, oa1, 0, 0, 0); } \
                _Pragma("unroll") for (int ks = 0; ks < 2; ++ks) { const bf16x8 bb = *(const bf16x8*)(PM + (tt * 16 + l15) * RSS + (ks * 32 + q4 * 8) * 2); \
                    const bf16x8 a0 = *(const bf16x8*)(VT + (l15) * RSS + (ks * 32 + q4 * 8) * 2), a1 = *(const bf16x8*)(VT + (16 + l15) * RSS + (ks * 32 + q4 * 8) * 2); \
                    oa0 = __builtin_amdgcn_mfma_f32_16x16x32_bf16(a0, bb, oa0, 0, 0, 0); oa1 = __builtin_amdgcn_mfma_f32_16x16x32_bf16(a1, bb, oa1, 0, 0, 0); } \
                const size_t row = (size_t)(b * SEQ + (n) * 64 + tt * 16 + l15); const int col = h * 128 + vs * 32 + q4 * 4; \
                u32x2 w0, w1; w0.x = cvt_pk_bf16(oa0[0], oa0[1]); w0.y = cvt_pk_bf16(oa0[2], oa0[3]); w1.x = cvt_pk_bf16(oa1[0], oa1[1]); w1.y = cvt_pk_bf16(oa1[2], oa1[3]); \
                *(u32x2*)(p.o + row * 1024 + col) = w0; *(u32x2*)(p.o + row * 1024 + col + 16) = w1; \
                float s0 = oa0[0] * oa0[0] + oa0[1] * oa0[1] + oa0[2] * oa0[2] + oa0[3] * oa0[3], s1 = oa1[0] * oa1[0] + oa1[1] * oa1[1] + oa1[2] * oa1[2] + oa1[3] * oa1[3]; \
                s0 += __shfl_xor(s0, 16); s0 += __shfl_xor(s0, 32); s1 += __shfl_xor(s1, 16); s1 += __shfl_xor(s1, 32); \
                if (q4 == 0) *(f32x2*)(p.ssq_h + row * 64 + h * 8 + vs * 2) = (f32x2){s0, s1}; \
            } else { \
                sacc[0] *= dcur0; sacc[1] *= dcur0; sacc[2] *= dcur1; sacc[3] *= dcur1; \
                _Pragma("unroll") for (int ks = 0; ks < 2; ++ks) { \
                    const bf16x8 a0 = *(const bf16x8*)(KLT + (16 * wd + l15) * RSS + (ks * 32 + q4 * 8) * 2), a1 = *(const bf16x8*)(KLT + (16 * wd + 16 + l15) * RSS + (ks * 32 + q4 * 8) * 2); \
                    const bf16x8 b0 = *(const bf16x8*)(VT + (l15) * RSS + (ks * 32 + q4 * 8) * 2), b1 = *(const bf16x8*)(VT + (16 + l15) * RSS + (ks * 32 + q4 * 8) * 2); \
                    sacc[0] = __builtin_amdgcn_mfma_f32_16x16x32_bf16(a0, b0, sacc[0], 0, 0, 0); sacc[1] = __builtin_amdgcn_mfma_f32_16x16x32_bf16(a0, b1, sacc[1], 0, 0, 0); \
                    sacc[2] = __builtin_amdgcn_mfma_f32_16x16x32_bf16(a1, b0, sacc[2], 0, 0, 0); sacc[3] = __builtin_amdgcn_mfma_f32_16x16x32_bf16(a1, b1, sacc[3], 0, 0, 0); } \
                _Pragma("unroll") for (int i = 0; i < 4; ++i) { const int dt = wd + (i >> 1), v2 = i & 1; \
                    u32x2 w; w.x = cvt_pk_bf16(sacc[i][0], sacc[i][1]); w.y = cvt_pk_bf16(sacc[i][2], sacc[i][3]); \
                    *(u32x2*)(STn + (v2 * 16 + l15) * RSD + (16 * dt + q4 * 4) * 2) = w; } \
            } \
            __syncthreads(); } while (0)
        P3S_LOAD(0, 0); P3S_LOAD(1, 1); P3S_LOAD(2, 2);
        P3S_PUT(0, 0);
        __syncthreads();
        _Pragma("unroll") for (int n = 0; n < 32; ++n) { P3S_STEP((n + 1) % 3, n); }
#undef P3S_STEP
#undef P3S_PUT
#undef P3S_LOAD
    }
}

__device__ __forceinline__ void phase3b(const Params& p) {
    const int T = gridDim.x * 512, g = blockIdx.x * 512 + threadIdx.x;
    for (int e = g; e < NTOK * 128; e += T) {
        const size_t r = (size_t)(e >> 7); const int cgp = e & 127, h = cgp >> 4, v0 = (cgp & 15) * 8;
        const u32x4 o8 = __builtin_nontemporal_load((const u32x4*)(p.o + r * 1024 + cgp * 8)), z8 = __builtin_nontemporal_load((const u32x4*)(p.proj + r * 8192 + 3072 + cgp * 8));
        const f32x4 s0 = *(const f32x4*)(p.ssq_h + r * 64 + h * 8), s1 = *(const f32x4*)(p.ssq_h + r * 64 + h * 8 + 4);
        const float ss = (s0[0] + s0[1]) + (s0[2] + s0[3]) + (s1[0] + s1[1]) + (s1[2] + s1[3]);
        const float rstd = rsqrtf(ss * (1.0f / 128.0f) + EPSV);
        const f32x4 g0 = *(const f32x4*)(p.g_head + v0), g1 = *(const f32x4*)(p.g_head + v0 + 4);
        u32x4 w;
        w.x = cvt_pk_bf16(bflo(o8.x) * rstd * g0[0] * siluf_(bflo(z8.x)), bfhi(o8.x) * rstd * g0[1] * siluf_(bfhi(z8.x)));
        w.y = cvt_pk_bf16(bflo(o8.y) * rstd * g0[2] * siluf_(bflo(z8.y)), bfhi(o8.y) * rstd * g0[3] * siluf_(bfhi(z8.y)));
        w.z = cvt_pk_bf16(bflo(o8.z) * rstd * g1[0] * siluf_(bflo(z8.z)), bfhi(o8.z) * rstd * g1[1] * siluf_(bfhi(z8.z)));
        w.w = cvt_pk_bf16(bflo(o8.w) * rstd * g1[2] * siluf_(bflo(z8.w)), bfhi(o8.w) * rstd * g1[3] * siluf_(bfhi(z8.w)));
        *(u32x4*)(p.hy + r * 2048 + cgp * 8) = w;
    }
    for (int e = g; e < (NTOK / 16) * 128; e += T) {
        const int rb = e >> 7, cgp = e & 127, c0 = cgp * 8;
        const size_t r0 = (size_t)rb * 16; const int t0 = (int)(r0 & (SEQ - 1));
        float w0[8], w1[8], w2[8], bs[8], u1[8], u2[8];
#pragma unroll
        for (int j = 0; j < 8; ++j) { w0[j] = p.conv_w[c0 + j]; w1[j] = p.conv_w[1024 + c0 + j]; w2[j] = p.conv_w[2048 + c0 + j]; bs[j] = p.conv_b[c0 + j]; u1[j] = 0.f; u2[j] = 0.f; }
        if (t0 > 0) {
            const u32x4 ga = *(const u32x4*)(p.proj + (r0 - 1) * 8192 + 5120 + c0), va = *(const u32x4*)(p.proj + (r0 - 1) * 8192 + 6144 + c0);
            const u32x4 gb = *(const u32x4*)(p.proj + (r0 - 2) * 8192 + 5120 + c0), vb = *(const u32x4*)(p.proj + (r0 - 2) * 8192 + 6144 + c0);
            u1[0] = bflo(ga.x) * bflo(va.x); u1[1] = bfhi(ga.x) * bfhi(va.x); u1[2] = bflo(ga.y) * bflo(va.y); u1[3] = bfhi(ga.y) * bfhi(va.y);
            u1[4] = bflo(ga.z) * bflo(va.z); u1[5] = bfhi(ga.z) * bfhi(va.z); u1[6] = bflo(ga.w) * bflo(va.w); u1[7] = bfhi(ga.w) * bfhi(va.w);
            u2[0] = bflo(gb.x) * bflo(vb.x); u2[1] = bfhi(gb.x) * bfhi(vb.x); u2[2] = bflo(gb.y) * bflo(vb.y); u2[3] = bfhi(gb.y) * bfhi(vb.y);
            u2[4] = bflo(gb.z) * bflo(vb.z); u2[5] = bfhi(gb.z) * bfhi(vb.z); u2[6] = bflo(gb.w) * bflo(vb.w); u2[7] = bfhi(gb.w) * bfhi(vb.w);
        }
#pragma unroll 4
        for (int i = 0; i < 16; ++i) {
            const bf16_t* rp = p.proj + (r0 + i) * 8192 + c0;
            const u32x4 gbb = __builtin_nontemporal_load((const u32x4*)(rp + 4096)), gcc = __builtin_nontemporal_load((const u32x4*)(rp + 5120)), vbb = __builtin_nontemporal_load((const u32x4*)(rp + 6144)), zb = __builtin_nontemporal_load((const u32x4*)(rp + 7168));
            float u[8], gv[8], zv[8], y[8];
            u[0] = bflo(gcc.x) * bflo(vbb.x); u[1] = bfhi(gcc.x) * bfhi(vbb.x); u[2] = bflo(gcc.y) * bflo(vbb.y); u[3] = bfhi(gcc.y) * bfhi(vbb.y);
            u[4] = bflo(gcc.z) * bflo(vbb.z); u[5] = bfhi(gcc.z) * bfhi(vbb.z); u[6] = bflo(gcc.w) * bflo(vbb.w); u[7] = bfhi(gcc.w) * bfhi(vbb.w);
            gv[0] = bflo(gbb.x); gv[1] = bfhi(gbb.x); gv[2] = bflo(gbb.y); gv[3] = bfhi(gbb.y); gv[4] = bflo(gbb.z); gv[5] = bfhi(gbb.z); gv[6] = bflo(gbb.w); gv[7] = bfhi(gbb.w);
            zv[0] = bflo(zb.x); zv[1] = bfhi(zb.x); zv[2] = bflo(zb.y); zv[3] = bfhi(zb.y); zv[4] = bflo(zb.z); zv[5] = bfhi(zb.z); zv[6] = bflo(zb.w); zv[7] = bfhi(zb.w);
#pragma unroll
            for (int j = 0; j < 8; ++j) { const float cv = bs[j] + w0[j] * u2[j] + w1[j] * u1[j] + w2[j] * u[j]; y[j] = gv[j] * cv * siluf_(zv[j]); u2[j] = u1[j]; u1[j] = u[j]; }
            u32x4 w; w.x = cvt_pk_bf16(y[0], y[1]); w.y = cvt_pk_bf16(y[2], y[3]); w.z = cvt_pk_bf16(y[4], y[5]); w.w = cvt_pk_bf16(y[6], y[7]);
            *(u32x4*)(p.hy + (r0 + i) * 2048 + 1024 + c0) = w;
        }
    }
}

__device__ __forceinline__ void phase6(const Params& p, const float dscale) {
    const int tid = threadIdx.x, wid = tid >> 6, lane = tid & 63;
    const int gw = blockIdx.x * 8 + wid, nw = gridDim.x * 8;
    for (int rowi = gw; rowi < NTOK; rowi += nw) {
        const size_t row = (size_t)rowi; const int b = rowi >> 11;
        float ss = (lane < 32) ? p.ssq_o[row * 32 + lane] : 0.f;
#pragma unroll
        for (int o = 1; o < 64; o <<= 1) ss += __shfl_xor(ss, o);
        const float rstd = rsqrtf(ss * (1.0f / DM) + EPSV);
#pragma unroll
        for (int i = 0; i < 8; ++i) { const int c = i * 256 + lane * 4;
            const f32x4 xv = __builtin_nontemporal_load((const f32x4*)(p.x + row * DM + c)), gt = *(const f32x4*)(p.mod + b * 6144 + 4096 + c), gp = *(const f32x4*)(p.g_post + c);
            const u32x2 ov = __builtin_nontemporal_load((const u32x2*)(p.outpre + row * DM + c));
            f32x4 r;
            r[0] = xv[0] + gt[0] * (bflo(ov.x) * rstd * gp[0]); r[1] = xv[1] + gt[1] * (bfhi(ov.x) * rstd * gp[1]);
            r[2] = xv[2] + gt[2] * (bflo(ov.y) * rstd * gp[2]); r[3] = xv[3] + gt[3] * (bfhi(ov.y) * rstd * gp[3]);
            __builtin_nontemporal_store(r * dscale, (f32x4*)(p.out + row * DM + c)); }
    }
}


#ifndef DIAG
#define DIAG 0
#endif
__device__ __forceinline__ void chk_sum(const void* buf, size_t bytes, unsigned long long* slot) {
    const u32x4* q = (const u32x4*)buf; const size_t n = bytes / 16; unsigned long long s = 0ull;
    for (size_t i = (size_t)blockIdx.x * 512 + threadIdx.x; i < n; i += (size_t)gridDim.x * 512) { const u32x4 v = q[i]; s += (unsigned long long)v.x + 3ull * v.y + 5ull * v.z + 7ull * v.w; }
    for (int o = 32; o; o >>= 1) s += __shfl_xor(s, o);
    if ((threadIdx.x & 63) == 0) atomicAdd(slot, s);
}
#define XB_TMO      128
#define XB_XCNT(j)  (256  + 64 * (j))
#define XB_XSUB(j)  (1280 + 64 * (j))
#define XB_XGEN(j)  (2304 + 64 * (j))
#define XB_TOP      3328
#define XB_TOPGEN   3392
#define XCD_BAR_WORDS 3456
#define XB_SPIN_CAP (1u << 22)
__device__ __forceinline__ unsigned xb_ld(unsigned* p)              { return __hip_atomic_load(p, __ATOMIC_RELAXED, __HIP_MEMORY_SCOPE_AGENT); }
__device__ __forceinline__ unsigned xb_add(unsigned* p, unsigned v) { return __hip_atomic_fetch_add(p, v, __ATOMIC_RELAXED, __HIP_MEMORY_SCOPE_AGENT); }
__device__ __forceinline__ unsigned xb_xcc_id() { return (unsigned)__builtin_amdgcn_s_getreg((3 << 11) | 20) & 0xFu; }
#define XB_SPIN(cond, bar) do { unsigned _sp = 0; while (cond) { __builtin_amdgcn_s_sleep(1); \
    if ((++_sp & 255u) == 0u) { if (xb_ld(&(bar)[XB_TMO])) break; if (_sp > XB_SPIN_CAP) { atomicAdd(&(bar)[XB_TMO], 1u); break; } } } } while (0)
struct XcdBarrier { unsigned* bar; unsigned x; volatile LAS unsigned* st; };
__device__ __forceinline__ XcdBarrier xcd_barrier_post(unsigned* bar, volatile LAS unsigned* st) {
    XcdBarrier b; b.bar = bar; b.x = xb_xcc_id(); b.st = st;
    if (threadIdx.x == 0) (void)xb_add(&bar[XB_XCNT(b.x)], 1u);
    return b;
}
__device__ __forceinline__ void xcd_barrier_complete(unsigned* bar, unsigned x, unsigned& nloc, unsigned& nx) {
    const unsigned G = gridDim.x * gridDim.y * gridDim.z;
    unsigned sum, cnt, mine, sp = 0u;
    for (;;) {
        sum = 0u; cnt = 0u; mine = 0u;
#pragma unroll
        for (unsigned j = 0; j < 16; ++j) { const unsigned c = xb_ld(&bar[XB_XCNT(j)]); sum += c; cnt += (c > 0u) ? 1u : 0u; mine = (j == x) ? c : mine; }
        if (sum == G) break;
        __builtin_amdgcn_s_sleep(1);
        if ((++sp & 255u) == 0u) { if (xb_ld(&bar[XB_TMO])) break; if (sp > XB_SPIN_CAP) { atomicAdd(&bar[XB_TMO], 1u); break; } }
    }
    nloc = mine > 0u ? mine : 1u; nx = cnt > 0u ? cnt : 1u;
}
__device__ __forceinline__ void xcd_barrier(const XcdBarrier& b) {
    asm volatile("s_waitcnt vmcnt(0)" ::: "memory");
    __syncthreads();
    if (threadIdx.x == 0) {
        unsigned* bar = b.bar;
        __builtin_amdgcn_s_waitcnt(0);
        unsigned nloc = b.st[0], nx = b.st[1];
        if (nloc == 0u) { xcd_barrier_complete(bar, b.x, nloc, nx); b.st[0] = nloc; b.st[1] = nx; }
        const unsigned old = xb_add(&bar[XB_XSUB(b.x)], 1u);
        const unsigned gen = old / nloc;
        if (old + 1u == (gen + 1u) * nloc) {
            __builtin_amdgcn_fence(__ATOMIC_RELEASE, "agent");
            asm volatile("s_waitcnt vmcnt(0)" ::: "memory");
            const unsigned og = xb_add(&bar[XB_TOP], 1u);
            const unsigned tg = og / nx;
            if (og + 1u == (tg + 1u) * nx) xb_add(&bar[XB_TOPGEN], 1u);
            else XB_SPIN(xb_ld(&bar[XB_TOPGEN]) == tg, bar);
            __builtin_amdgcn_fence(__ATOMIC_ACQUIRE, "agent");
            xb_add(&bar[XB_XGEN(b.x)], 1u);
            asm volatile("s_waitcnt vmcnt(0)" ::: "memory");
        } else {
            XB_SPIN(xb_ld(&bar[XB_XGEN(b.x)]) == gen, bar);
            __builtin_amdgcn_fence(__ATOMIC_ACQUIRE, "agent");
            asm volatile("s_waitcnt vmcnt(0)" ::: "memory");
        }
    }
    __syncthreads();
}
__device__ __forceinline__ void gsync(cg::grid_group& grid) {
    __builtin_amdgcn_fence(__ATOMIC_RELEASE, "agent");
    asm volatile("s_waitcnt vmcnt(0) lgkmcnt(0)" ::: "memory");
    grid.sync();
    __builtin_amdgcn_fence(__ATOMIC_ACQUIRE, "agent");
    asm volatile("s_waitcnt vmcnt(0)" ::: "memory");
    __syncthreads();
}
__global__ void __launch_bounds__(512, 2) mega(Params p) {
    extern __shared__ __attribute__((aligned(16))) unsigned char shm[];
    cg::grid_group grid = cg::this_grid();
    const bool multi = (p.ph_hi - p.ph_lo) > 1;
    if (p.ph_lo < 0) gsync(grid);
    volatile LAS unsigned* xst = (volatile LAS unsigned*)((LAS unsigned char*)shm + 131072);
    if (threadIdx.x == 0) { xst[0] = 0u; xst[1] = 0u; }
    __syncthreads();
    XcdBarrier xb; xb.bar = p.bar; xb.x = 0; xb.st = xst;
    if (multi) xb = xcd_barrier_post(p.bar, xst);
#define PH(n) if (p.ph_lo <= (n) && (n) < p.ph_hi)
#define GS(n) if (multi && p.ph_lo <= (n) && (n) + 1 < p.ph_hi) xcd_barrier(xb)
    PH(0) phase0(p, shm);
    GS(0);
    PH(1) phase1(p);
    GS(1);
#if DIAG
    if (multi) chk_sum(p.hy, (size_t)NTOK * 2048 * 2, p.chk + 2);
#endif
    PH(2) { pg8::StaticOrder S; S.init(NTOK, 12288, (int)gridDim.x, (int)blockIdx.x); pg8::Gemm g{p.hy, p.wt1, NTOK, 12288, 2048}; EpiG1 E{p.proj, p.merge, p.b_merge, p.chk};
      pg8::gemm_phase<EpiG1>((LAS unsigned char*)shm, g, S, E); }
    GS(2);
#if DIAG
    if (multi) chk_sum(p.proj, (size_t)NTOK * 8192 * 2, p.chk + 3);
#endif
    PH(3) { phase3a(p, shm); if (multi) xcd_barrier(xb); phase3s(p, shm); }
    GS(3);
    PH(4) phase3b(p);
    GS(4);
    PH(5) { pg8::StaticOrder S; S.init(NTOK, 2048, (int)gridDim.x, (int)blockIdx.x); pg8::Gemm g{p.hy, p.wt2, NTOK, 2048, 2048}; EpiG2 E{p.merge, p.mix, (bf16_t*)p.tmp};
      pg8::gemm_phase<EpiG2>((LAS unsigned char*)shm, g, S, E); }
    GS(5);
    PH(6) { pg8::StaticOrder S; S.init(NTOK, 2048, (int)gridDim.x, (int)blockIdx.x); pg8::Gemm g{p.mix, p.wt3, NTOK, 2048, 2048}; EpiG3 E{p.outpre, p.ssq_o};
      pg8::gemm_phase<EpiG3>((LAS unsigned char*)shm, g, S, E); }
    GS(6);
#if DIAG
    float dscale = 1.0f;
    if (multi) {
        chk_sum(p.wt1, (size_t)(12288 + 2048 + 2048) * 2048 * 2, p.chk + 0);
        chk_sum(p.mod, (size_t)8 * 6144 * 4, p.chk + 1);
        chk_sum(p.o, (size_t)NTOK * 1024 * 2, p.chk + 5);
        chk_sum(p.ssq_h, (size_t)NTOK * 64 * 4, p.chk + 6);
        chk_sum(p.hy, (size_t)NTOK * 2048 * 2, p.chk + 7);
        chk_sum(p.mix, (size_t)NTOK * 2048 * 2, p.chk + 8);
        chk_sum(p.outpre, (size_t)NTOK * 2048 * 2, p.chk + 9);
        chk_sum(p.ssq_o, (size_t)NTOK * 32 * 4, p.chk + 10);
        chk_sum(p.merge, (size_t)NTOK * 4096 * 2, p.chk + 4);
        chk_sum(p.b_merge, (size_t)4096 * 4, p.chk + 13);
        gsync(grid);
        if (blockIdx.x == 0 && threadIdx.x == 0) {
            unsigned long long m = 0ull;
            if (p.chk[31] == 0x1234567887654321ull && p.chk[14] != p.chk[16 + 14]) m = 14ull;
            else if (p.chk[31] == 0x1234567887654321ull) { for (int k = 0; k < 11; ++k) if (p.chk[k] != p.chk[16 + k]) { m = (unsigned long long)(k + 1); break; } }
            for (int k = 0; k < 15; ++k) p.chk[16 + k] = p.chk[k];
            p.chk[31] = 0x1234567887654321ull; p.chk[32] = m;
        }
        gsync(grid);
        dscale = 1.0f + 0.2f * (float)__hip_atomic_load(p.chk + 32, __ATOMIC_RELAXED, __HIP_MEMORY_SCOPE_AGENT);
    }
    PH(7) phase6(p, dscale);
#else
    PH(7) phase6(p, 1.0f);
#endif
#undef PH
#undef GS
}

extern "C" void kernel_launch(void* const* d_in, const int* in_sizes, int n_in, void* d_out, int out_size, void* d_ws, size_t ws_size, hipStream_t stream) {
    (void)in_sizes; (void)n_in; (void)out_size;
    Params p{};
    p.x = (const float*)d_in[0]; p.c = (const float*)d_in[1]; p.w_ada = (const float*)d_in[2]; p.b_ada = (const float*)d_in[3]; p.g_pre = (const float*)d_in[4];
    p.w_in = (const float*)d_in[5]; p.lb_logits = (const float*)d_in[6]; p.g_head = (const float*)d_in[7]; p.conv_w = (const float*)d_in[8]; p.conv_b = (const float*)d_in[9];
    p.w_up_a = (const float*)d_in[10]; p.w_up_b = (const float*)d_in[11]; p.w_merge = (const float*)d_in[12]; p.b_merge = (const float*)d_in[13]; p.w_o = (const float*)d_in[14]; p.g_post = (const float*)d_in[15];
    p.out = (float*)d_out;
    unsigned char* ws = (unsigned char*)d_ws; size_t off = 0;
    auto take = [&](size_t bytes) { unsigned char* r = ws + off; off += (bytes + 255) & ~(size_t)255; return r; };
    p.wt1 = (bf16_t*)take((size_t)12288 * 2048 * 2);
    p.wt2 = (bf16_t*)take((size_t)2048 * 2048 * 2);
    p.wt3 = (bf16_t*)take((size_t)2048 * 2048 * 2);
    p.hy = (bf16_t*)take((size_t)NTOK * 2048 * 2);
    p.proj = (bf16_t*)take((size_t)NTOK * 8192 * 2);
    p.o = (bf16_t*)take((size_t)NTOK * 1024 * 2);
    p.mod = (float*)take((size_t)8 * 6144 * 4);
    p.ssq_h = (float*)take((size_t)NTOK * 64 * 4);
    p.ssq_o = (float*)take((size_t)NTOK * 32 * 4);
    p.bar = (unsigned*)take((size_t)XCD_BAR_WORDS * 4);
    p.img = take((size_t)2048 * IMG_BYTES);
    p.chk = (unsigned long long*)take(512);
    if (off > ws_size) return;
    p.merge = (bf16_t*)d_out;
    p.mix = p.proj;
    p.outpre = p.proj + (size_t)NTOK * 2048;
    p.tmp = (float*)(p.proj + (size_t)NTOK * 4096);
    static int grid_blocks = 0;
    if (!grid_blocks) {
        hipFuncSetAttribute((const void*)mega, hipFuncAttributeMaxDynamicSharedMemorySize, LDS_BYTES);
        int dev = 0, cus = 0, per_cu = 0;
        hipGetDevice(&dev);
        hipDeviceGetAttribute(&cus, hipDeviceAttributeMultiprocessorCount, dev);
        hipOccupancyMaxActiveBlocksPerMultiprocessor(&per_cu, mega, 512, LDS_BYTES);
        if (per_cu < 1) per_cu = 1;
        if (per_cu > 1) per_cu = 1;
        grid_blocks = cus * per_cu;
    }
#ifndef N_LAUNCH_SPLIT
#define N_LAUNCH_SPLIT 1
#endif
#if DIAG
    hipMemsetAsync(p.chk, 0, 128, stream);
#endif
    hipMemsetAsync(p.bar, 0, (size_t)XCD_BAR_WORDS * 4, stream);
    if (N_LAUNCH_SPLIT == 1) {
        p.ph_lo = 0; p.ph_hi = 8;
        void* args[] = {&p};
        hipError_t e = hipLaunchCooperativeKernel((void*)mega, dim3(grid_blocks), dim3(512), args, LDS_BYTES, stream);
        if (e != hipSuccess) fprintf(stderr, "cooperative launch failed: %s (grid %d)\n", hipGetErrorString(e), grid_blocks);
    } else {
        for (int ph = 0; ph < 8; ++ph) { p.ph_lo = ph; p.ph_hi = ph + 1; hipLaunchKernelGGL(mega, dim3(grid_blocks), dim3(512), LDS_BYTES, stream, p); }
    }
}
```

```cpp
#include <hip/hip_runtime.h>
#include <hip/hip_cooperative_groups.h>
#include <cstdio>
namespace cg = cooperative_groups;

#define LAS __attribute__((address_space(3)))
typedef unsigned short bf16_t;
typedef short bf16x8 __attribute__((ext_vector_type(8)));
typedef float f32x4 __attribute__((ext_vector_type(4)));
typedef float f32x2 __attribute__((ext_vector_type(2)));
typedef unsigned u32x4 __attribute__((ext_vector_type(4)));
typedef unsigned u32x2 __attribute__((ext_vector_type(2)));

constexpr int NTOK = 16384, DM = 2048, SEQ = 2048;
constexpr int LDS_BYTES = 131072 + 256;
#define EPSV 1e-6f

struct Params {
    const float *x, *c, *w_ada, *b_ada, *g_pre, *w_in, *lb_logits, *g_head, *conv_w, *conv_b, *w_up_a, *w_up_b, *w_merge, *b_merge, *w_o, *g_post;
    float* out;
    bf16_t *wt1, *wt2, *wt3, *hy, *proj, *merge, *o, *mix, *outpre;
    float *mod, *ssq_h, *ssq_o, *tmp;
    int ph_lo, ph_hi;
    unsigned long long* chk;
    unsigned* bar;
    unsigned char* img;
};

typedef __bf16 bf16x2_t __attribute__((ext_vector_type(2)));
__device__ __forceinline__ unsigned cvt_pk_bf16(float lo, float hi) { const f32x2 v = {lo, hi}; const bf16x2_t r = __builtin_convertvector(v, bf16x2_t); return __builtin_bit_cast(unsigned, r); }
__device__ __forceinline__ float bflo(unsigned w) { return __uint_as_float(w << 16); }
__device__ __forceinline__ float bfhi(unsigned w) { return __uint_as_float(w & 0xffff0000u); }
__device__ __forceinline__ float sigmoidf_(float x) { return __builtin_amdgcn_rcpf(1.0f + __expf(-x)); }
__device__ __forceinline__ float siluf_(float x) { return x * sigmoidf_(x); }

namespace pg8 {
constexpr int BM = 256, BK = 64, HALF = 128, HTB = HALF * BK * 2, STAGE_BYTES = 8 * HTB, NXCD = 8, WGM = 8;
__host__ __device__ __forceinline__ int lds_byte(int r, int c) { const int st = (r >> 4) * 2 + (c >> 5), rr = r & 15, cc = c & 31, ob = rr * 64 + cc * 2; return st * 1024 + (ob ^ (((ob >> 9) & 1) << 5)); }
__host__ __device__ __forceinline__ void stage_rc(int b, int& R, int& C) { const int st = b / 1024, sb = b % 1024, swz = sb ^ (((sb >> 9) & 1) << 5); R = (st >> 1) * 16 + swz / 64; C = (st & 1) * 32 + (swz % 64) / 2; }
__host__ __device__ __forceinline__ int perm32(int rho) { const int n = rho >> 4, i = rho & 15; return 8 * (i >> 2) + 4 * n + (i & 3); }
struct Unit { int pm, pn; };
struct Gemm { const bf16_t* A; const bf16_t* Bt; int M, N, K; };
struct StaticOrder {
    int nM, nN, nwg, G, c, rot;
    __device__ void init(int M, int N, int G_, int c_, int rot_ = 0) { nM = M / BM; nN = N / BM; nwg = nM * nN; G = G_; c = c_; rot = rot_; }
    __device__ bool next(int i, Unit& u) const {
        const long L = (long)i * G + c; if (L >= nwg) return false;
        int wgid = (int)L; { const int q = nwg / NXCD, r = nwg % NXCD, xcd = wgid % NXCD, off = wgid / NXCD; wgid = (xcd < r ? xcd * (q + 1) : r * (q + 1) + (xcd - r) * q) + off; }
        const int nig = WGM * nN, gid = wgid / nig, fm = gid * WGM, gsz = (nM - fm) < WGM ? (nM - fm) : WGM;
        u.pm = fm + ((wgid % nig) % gsz); u.pn = ((wgid % nig) / gsz + rot) % nN; return true;
    }
};

template <class Epi>
__device__ __forceinline__ void gemm_phase(LAS unsigned char* lds, const Gemm g, const StaticOrder& S, const Epi& E) {
    const int tid = threadIdx.x, wid = __builtin_amdgcn_readfirstlane(tid >> 6), lane = tid & 63, wr = wid >> 2, wc = wid & 3, fr = lane & 15, fq = lane >> 4;
    constexpr int KS = Epi::KSPLIT; const int K = g.K, nt = K / BK / KS; const size_t khstep = (size_t)(K / KS) * 2;
    unsigned voffA[2], voffB[2];
#pragma unroll
    for (int i = 0; i < 2; ++i) { int R, C; stage_rc(tid * 16 + i * 8192, R, C); const int Rb = Epi::PERM ? ((R & ~31) + perm32(R & 31)) : R;
        voffA[i] = (unsigned)(R * K + C) * 2u; voffB[i] = (unsigned)(Rb * K + C) * 2u; }
    const size_t kstep = (size_t)(BK * 2);
    const size_t hstep = (size_t)HALF * K * 2;
    const size_t tstep = 2 * hstep;
    const unsigned ldsw = (unsigned)wid * 1024u;
    const int aoff = lds_byte(wr * 64 + fr, fq * 8), boff = lds_byte(wc * 32 + fr, fq * 8);
#define PG8_SA(b, h) (((b) * 2 + (h)) * HTB)
#define PG8_SB(b, h) ((4 + (b) * 2 + (h)) * HTB)
#define PG8_STAGE(bufoff, gbase, voff) do { _Pragma("unroll") for (int _i = 0; _i < 2; ++_i) \
        __builtin_amdgcn_global_load_lds((const unsigned*)((const char*)(gbase) + (voff)[_i]), (LAS unsigned*)(lds + (bufoff) + ldsw + _i * 8192), 16, 0, 0); } while (0)
#define PG8_LDA(dst, b, h) do { _Pragma("unroll") for (int m = 0; m < 4; ++m) _Pragma("unroll") for (int k = 0; k < 2; ++k) dst[m][k] = *(const LAS bf16x8*)(lds + PG8_SA(b, h) + aoff + m * 2048 + k * 1024); } while (0)
#define PG8_LDB(dst, b, h) do { _Pragma("unroll") for (int n = 0; n < 2; ++n) _Pragma("unroll") for (int k = 0; k < 2; ++k) dst[n][k] = *(const LAS bf16x8*)(lds + PG8_SB(b, h) + boff + n * 2048 + k * 1024); } while (0)
#define PG8_MMA(ai, bj, At, Bt) do { __builtin_amdgcn_s_setprio(1); _Pragma("unroll") for (int m = 0; m < 4; ++m) _Pragma("unroll") for (int n = 0; n < 2; ++n) _Pragma("unroll") for (int k = 0; k < 2; ++k) \
        acc[ai][bj][m][n] = __builtin_amdgcn_mfma_f32_16x16x32_bf16(Bt[n][k], At[m][k], acc[ai][bj][m][n], 0, 0, 0); __builtin_amdgcn_s_setprio(0); } while (0)
#define PG8_WAIT_V(n) asm volatile("s_waitcnt vmcnt(" #n ")" ::: "memory")
#define PG8_WAIT_L(n) asm volatile("s_waitcnt lgkmcnt(" #n ")" ::: "memory")
#define PG8_BAR __builtin_amdgcn_s_barrier()
#define PG8_SCHED __builtin_amdgcn_sched_barrier(0)
    Unit cur, nxt; int ui = 0;
    if (!S.next(0, cur)) return;
    f32x4 acc[2][2][4][2];
#pragma unroll
    for (int a = 0; a < 2; ++a)
#pragma unroll
        for (int b = 0; b < 2; ++b)
#pragma unroll
            for (int m = 0; m < 4; ++m)
#pragma unroll
                for (int n = 0; n < 2; ++n) acc[a][b][m][n] = (f32x4){0.f, 0.f, 0.f, 0.f};
    bf16x8 At[4][2], B0[2][2], B1[2][2];
    const char* cA = (const char*)g.A + (size_t)cur.pm * tstep; const char* cB = (const char*)g.Bt + (size_t)cur.pn * tstep;
    PG8_STAGE(PG8_SB(0, 0), cB, voffB); PG8_STAGE(PG8_SA(0, 0), cA, voffA); PG8_STAGE(PG8_SB(0, 1), cB + hstep, voffB); PG8_STAGE(PG8_SA(0, 1), cA + hstep, voffA);
    if (wr == 1) PG8_BAR;
    PG8_WAIT_V(4); PG8_BAR;
    PG8_STAGE(PG8_SB(1, 0), cB + kstep, voffB); PG8_STAGE(PG8_SA(1, 0), cA + kstep, voffA); PG8_STAGE(PG8_SB(1, 1), cB + hstep + kstep, voffB);
    PG8_WAIT_V(6); PG8_BAR;
    auto kloop = [&](const char* cA, const char* cB, const char* nA, const char* nB) __attribute__((always_inline)) {
        for (int t = 0; t < nt; t += 2) {
            const bool last = (t == nt - 2);
            const char* a1 = cA + (size_t)(t + 1) * kstep;
            const char* a2 = last ? nA : cA + (size_t)(t + 2) * kstep; const char* b2 = last ? nB : cB + (size_t)(t + 2) * kstep;
            const char* a3 = a2 + kstep; const char* b3 = b2 + kstep;
            PG8_LDB(B0, 0, 0); PG8_SCHED; PG8_LDA(At, 0, 0); PG8_STAGE(PG8_SA(1, 1), a1 + hstep, voffA);
            PG8_WAIT_L(8); PG8_BAR; PG8_WAIT_L(0); PG8_MMA(0, 0, At, B0); PG8_BAR; PG8_SCHED;
            PG8_LDB(B1, 0, 1); PG8_STAGE(PG8_SB(0, 0), b2, voffB);
            PG8_BAR; PG8_WAIT_L(0); PG8_MMA(0, 1, At, B1); PG8_BAR;
            PG8_LDA(At, 0, 1); PG8_STAGE(PG8_SA(0, 0), a2, voffA);
            PG8_BAR; PG8_WAIT_L(0); PG8_MMA(1, 0, At, B0); PG8_BAR; PG8_SCHED;
            PG8_STAGE(PG8_SB(0, 1), b2 + hstep, voffB);
            PG8_WAIT_V(6); PG8_BAR; PG8_MMA(1, 1, At, B1); PG8_BAR;
            PG8_LDB(B0, 1, 0); PG8_SCHED; PG8_LDA(At, 1, 0); PG8_STAGE(PG8_SA(0, 1), a2 + hstep, voffA);
            PG8_WAIT_L(8); PG8_BAR; PG8_WAIT_L(0); PG8_MMA(0, 0, At, B0); PG8_BAR; PG8_SCHED;
            PG8_LDB(B1, 1, 1); PG8_STAGE(PG8_SB(1, 0), b3, voffB);
            PG8_BAR; PG8_WAIT_L(0); PG8_MMA(0, 1, At, B1); PG8_BAR;
            PG8_LDA(At, 1, 1); PG8_STAGE(PG8_SA(1, 0), a3, voffA);
            PG8_BAR; PG8_WAIT_L(0); PG8_MMA(1, 0, At, B0); PG8_BAR; PG8_SCHED;
            PG8_STAGE(PG8_SB(1, 1), b3 + hstep, voffB);
            PG8_WAIT_V(6); PG8_BAR; PG8_MMA(1, 1, At, B1); PG8_BAR;
        }
    };
    for (;;) {
        const int kh = (KS == 1) ? 0 : (ui % KS), nkh = (KS == 1) ? 0 : ((ui + 1) % KS);
        bool has_next = true; nxt = cur;
        if (nkh == 0) has_next = S.next((ui + 1) / KS, nxt);
        const char* nA = has_next ? (const char*)g.A + (size_t)nxt.pm * tstep + nkh * khstep : cA; const char* nB = has_next ? (const char*)g.Bt + (size_t)nxt.pn * tstep + nkh * khstep : cB;
        kloop(cA, cB, nA, nB);
        E(acc, cur, kh, wr, wc, fr, fq);
        if (!has_next) break;
#pragma unroll
        for (int a = 0; a < 2; ++a)
#pragma unroll
            for (int b = 0; b < 2; ++b)
#pragma unroll
                for (int m = 0; m < 4; ++m)
#pragma unroll
                    for (int n = 0; n < 2; ++n) acc[a][b][m][n] = (f32x4){0.f, 0.f, 0.f, 0.f};
        cur = nxt; cA = nA; cB = nB; ++ui;
    }
    PG8_WAIT_V(0);
    if (wr == 0) PG8_BAR;
    PG8_BAR;
#undef PG8_SA
#undef PG8_SB
#undef PG8_STAGE
#undef PG8_LDA
#undef PG8_LDB
#undef PG8_MMA
#undef PG8_WAIT_V
#undef PG8_WAIT_L
#undef PG8_BAR
#undef PG8_SCHED
}
}
using pg8::Unit;

struct EpiG1 {
    static constexpr bool PERM = true; static constexpr int KSPLIT = 1;
    bf16_t* proj; bf16_t* merge; const float* b_merge; unsigned long long* chk;
    __device__ __forceinline__ void operator()(const f32x4 (&acc)[2][2][4][2], const Unit& u, int kh, int wr, int wc, int fr, int fq) const {
        const int row0 = u.pm * 256 + wr * 64 + fr;
        if (u.pn < 32) {
            const int col0 = u.pn * 256 + wc * 32 + 8 * fq;
#pragma unroll
            for (int ai = 0; ai < 2; ++ai)
#pragma unroll
                for (int m = 0; m < 4; ++m) { bf16_t* rowp = proj + (size_t)(row0 + ai * 128 + m * 16) * 8192 + col0;
#pragma unroll
                    for (int bj = 0; bj < 2; ++bj) { const f32x4 v0 = acc[ai][bj][m][0], v1 = acc[ai][bj][m][1];
                        u32x4 w; w.x = cvt_pk_bf16(v0[0], v0[1]); w.y = cvt_pk_bf16(v0[2], v0[3]); w.z = cvt_pk_bf16(v1[0], v1[1]); w.w = cvt_pk_bf16(v1[2], v1[3]);
                        __builtin_nontemporal_store(w, (u32x4*)(rowp + bj * 128)); } }
        } else {
            const int col0 = (u.pn - 32) * 256 + wc * 32 + 8 * fq;
            bf16_t* tb = merge + ((size_t)(u.pm * 16 + (u.pn - 32)) * 65536) + (size_t)(wr * 4 + wc) * 8192 + (size_t)(fq * 16 + fr) * 8;
            f32x4 bv[2][2];
#pragma unroll
            for (int bj = 0; bj < 2; ++bj)
#pragma unroll
                for (int n = 0; n < 2; ++n) bv[bj][n] = *(const f32x4*)(b_merge + col0 + bj * 128 + 4 * n);
#pragma unroll
            for (int g = 0; g < 4; ++g) {
#pragma unroll
                for (int j = 0; j < 4; ++j) { const int ai = g >> 1, m = (g & 1) * 2 + (j >> 1), bj = j & 1;
                    f32x4 v0 = acc[ai][bj][m][0] + bv[bj][0], v1 = acc[ai][bj][m][1] + bv[bj][1];
#pragma unroll
                    for (int e = 0; e < 4; ++e) { v0[e] = sigmoidf_(v0[e]); v1[e] = sigmoidf_(v1[e]); }
                    u32x4 w; w.x = cvt_pk_bf16(v0[0], v0[1]); w.y = cvt_pk_bf16(v0[2], v0[3]); w.z = cvt_pk_bf16(v1[0], v1[1]); w.w = cvt_pk_bf16(v1[2], v1[3]);
                    __builtin_nontemporal_store(w, (u32x4*)(tb + j * 512)); }
                tb += 2048; asm volatile("" : "+v"(tb)); }
        }
    }
};
struct EpiG2 {
    static constexpr bool PERM = true; static constexpr int KSPLIT = 2;
    const bf16_t* merge; bf16_t* mix; bf16_t* park;
    __device__ __forceinline__ void operator()(const f32x4 (&acc)[2][2][4][2], const Unit& u, int kh, int wr, int wc, int fr, int fq) const {
        const int row0 = u.pm * 256 + wr * 64 + fr, col0 = u.pn * 256 + wc * 32 + 8 * fq;
        const size_t lo = (size_t)(wr * 4 + wc) * 8192 + (size_t)(fq * 16 + fr) * 8;
        bf16_t* pk = park + (size_t)blockIdx.x * 65536 + lo;
        if (kh == 0) {
            const bf16_t* ta = merge + ((size_t)(u.pm * 16 + u.pn) * 65536) + lo;
#pragma unroll
            for (int g = 0; g < 4; ++g) {
                u32x4 a[4];
#pragma unroll
                for (int j = 0; j < 4; ++j) a[j] = __builtin_nontemporal_load((const u32x4*)(ta + j * 512));
#pragma unroll
                for (int j = 0; j < 4; ++j) { const int ai = g >> 1, m = (g & 1) * 2 + (j >> 1), bj = j & 1; const u32x4 aa = a[j];
                    const f32x4 v0 = acc[ai][bj][m][0], v1 = acc[ai][bj][m][1];
                    u32x4 w; w.x = cvt_pk_bf16(v0[0] * bflo(aa.x), v0[1] * bfhi(aa.x)); w.y = cvt_pk_bf16(v0[2] * bflo(aa.y), v0[3] * bfhi(aa.y));
                    w.z = cvt_pk_bf16(v1[0] * bflo(aa.z), v1[1] * bfhi(aa.z)); w.w = cvt_pk_bf16(v1[2] * bflo(aa.w), v1[3] * bfhi(aa.w));
                    *(u32x4*)(pk + j * 512) = w; }
                ta += 2048; pk += 2048; asm volatile("" : "+v"(ta), "+v"(pk)); }
        } else {
            const bf16_t* tbm = merge + ((size_t)(u.pm * 16 + 8 + u.pn) * 65536) + lo;
            bf16_t* mp = mix + (size_t)row0 * 2048 + col0;
#pragma unroll
            for (int g = 0; g < 8; ++g) {
                u32x4 b[2], t[2];
#pragma unroll
                for (int j = 0; j < 2; ++j) { b[j] = __builtin_nontemporal_load((const u32x4*)(tbm + ((g & 1) * 2 + j) * 512)); t[j] = __builtin_nontemporal_load((const u32x4*)(pk + ((g & 1) * 2 + j) * 512)); }
#pragma unroll
                for (int j = 0; j < 2; ++j) { const int ai = g >> 2, m = g & 3, bj = j; const u32x4 bb = b[j], tt = t[j];
                    const f32x4 v0 = acc[ai][bj][m][0], v1 = acc[ai][bj][m][1];
                    u32x4 w; w.x = cvt_pk_bf16(bflo(tt.x) + v0[0] * bflo(bb.x), bfhi(tt.x) + v0[1] * bfhi(bb.x)); w.y = cvt_pk_bf16(bflo(tt.y) + v0[2] * bflo(bb.y), bfhi(tt.y) + v0[3] * bfhi(bb.y));
                    w.z = cvt_pk_bf16(bflo(tt.z) + v1[0] * bflo(bb.z), bfhi(tt.z) + v1[1] * bfhi(bb.z)); w.w = cvt_pk_bf16(bflo(tt.w) + v1[2] * bflo(bb.w), bfhi(tt.w) + v1[3] * bfhi(bb.w));
                    *(u32x4*)(mp + bj * 128) = w; }
                if (g & 1) { tbm += 2048; pk += 2048; }
                mp += (g == 3) ? (size_t)(128 - 48) * 2048 : (size_t)16 * 2048;
                asm volatile("" : "+v"(tbm), "+v"(pk), "+v"(mp)); }
        }
    }
};
struct EpiG3 {
    static constexpr bool PERM = true; static constexpr int KSPLIT = 1;
    bf16_t* outpre; float* ssq;
    __device__ __forceinline__ void operator()(const f32x4 (&acc)[2][2][4][2], const Unit& u, int kh, int wr, int wc, int fr, int fq) const {
        const int row0 = u.pm * 256 + wr * 64 + fr, col0 = u.pn * 256 + wc * 32 + 8 * fq;
#pragma unroll
        for (int ai = 0; ai < 2; ++ai)
#pragma unroll
            for (int m = 0; m < 4; ++m) { const size_t r = (size_t)(row0 + ai * 128 + m * 16); float s = 0.f;
#pragma unroll
                for (int bj = 0; bj < 2; ++bj) { const f32x4 v0 = acc[ai][bj][m][0], v1 = acc[ai][bj][m][1];
                    s += v0[0] * v0[0] + v0[1] * v0[1] + v0[2] * v0[2] + v0[3] * v0[3] + v1[0] * v1[0] + v1[1] * v1[1] + v1[2] * v1[2] + v1[3] * v1[3];
                    u32x4 w; w.x = cvt_pk_bf16(v0[0], v0[1]); w.y = cvt_pk_bf16(v0[2], v0[3]); w.z = cvt_pk_bf16(v1[0], v1[1]); w.w = cvt_pk_bf16(v1[2], v1[3]);
                    *(u32x4*)(outpre + r * 2048 + col0 + bj * 128) = w; }
                s += __shfl_xor(s, 16); s += __shfl_xor(s, 32);
                if (fq == 0) ssq[r * 32 + u.pn * 4 + wc] = s; }
    }
};

__device__ __forceinline__ void gemv_item(const Params& p, int item, unsigned char* lds) {
    const int tid = threadIdx.x;
    float* cact = (float*)lds;
    float* red = (float*)(lds + 65536);
    for (int i = tid; i < 8 * 2048; i += 512) cact[(i & 2047) * 8 + (i >> 11)] = siluf_(p.c[i]);
    __syncthreads();
    const int col = tid & 31, dg = tid >> 5;
    const float* wp = p.w_ada + (size_t)dg * 6144 + item * 32 + col;
    f32x4 a0 = {0.f, 0.f, 0.f, 0.f}, a1 = {0.f, 0.f, 0.f, 0.f};
#pragma unroll 16
    for (int i = 0; i < 128; ++i) { const float w = __builtin_nontemporal_load(wp + (size_t)i * 16 * 6144); const int d = dg + 16 * i;
        const f32x4 c0 = *(const f32x4*)(cact + d * 8), c1 = *(const f32x4*)(cact + d * 8 + 4);
        a0 += c0 * w; a1 += c1 * w; }
    red[(dg * 8 + 0) * 32 + col] = a0[0]; red[(dg * 8 + 1) * 32 + col] = a0[1]; red[(dg * 8 + 2) * 32 + col] = a0[2]; red[(dg * 8 + 3) * 32 + col] = a0[3];
    red[(dg * 8 + 4) * 32 + col] = a1[0]; red[(dg * 8 + 5) * 32 + col] = a1[1]; red[(dg * 8 + 6) * 32 + col] = a1[2]; red[(dg * 8 + 7) * 32 + col] = a1[3];
    __syncthreads();
    if (tid < 256) { const int b = tid >> 5, c = tid & 31; float s = 0.f;
#pragma unroll
        for (int g = 0; g < 16; ++g) s += red[(g * 8 + b) * 32 + c];
        p.mod[b * 6144 + item * 32 + c] = s + p.b_ada[item * 32 + c]; }
    __syncthreads();
}
__device__ __forceinline__ void transpose_tile(const float* src, int N, int k0, int n0, bf16_t* dst, int dst_ld, int koff) {
    const int lane = threadIdx.x & 63, wid = threadIdx.x >> 6;
    const float* sp = src + (size_t)(k0 + wid * 32) * N + n0 + lane;
    float v[32];
#pragma unroll
    for (int i = 0; i < 32; ++i) v[i] = __builtin_nontemporal_load(sp + (size_t)i * N);
    bf16_t* dp = dst + (size_t)(n0 + lane) * dst_ld + koff + k0 + wid * 32;
#pragma unroll
    for (int c = 0; c < 4; ++c) { u32x4 w; w.x = cvt_pk_bf16(v[c * 8 + 0], v[c * 8 + 1]); w.y = cvt_pk_bf16(v[c * 8 + 2], v[c * 8 + 3]); w.z = cvt_pk_bf16(v[c * 8 + 4], v[c * 8 + 5]); w.w = cvt_pk_bf16(v[c * 8 + 6], v[c * 8 + 7]);
        *(u32x4*)(dp + c * 8) = w; }
}
__device__ __forceinline__ void transpose_item(const Params& p, int id) {
    if (id < 1024) { transpose_tile(p.w_in, 8192, (id >> 7) * 256, (id & 127) * 64, p.wt1, 2048, 0); }
    else if (id < 1536) { id -= 1024; transpose_tile(p.w_merge, 4096, (id >> 6) * 256, (id & 63) * 64, p.wt1 + (size_t)8192 * 2048, 2048, 0); }
    else if (id < 1664) { id -= 1536; transpose_tile(p.w_up_a, 2048, (id >> 5) * 256, (id & 31) * 64, p.wt2, 2048, 0); }
    else if (id < 1792) { id -= 1664; transpose_tile(p.w_up_b, 2048, (id >> 5) * 256, (id & 31) * 64, p.wt2, 2048, 1024); }
    else { id -= 1792; transpose_tile(p.w_o, 2048, (id >> 5) * 256, (id & 31) * 64, p.wt3, 2048, 0); }
}
__device__ __forceinline__ void phase0(const Params& p, unsigned char* lds) {
    constexpr int NG = 192, NTL = 2048;
    if (gridDim.x == 256) {
        const int c = blockIdx.x;
        if (c < NG) { gemv_item(p, c, lds); for (int i = 0; i < 7; ++i) transpose_item(p, c * 7 + i); }
        else { for (int i = 0; i < 11; ++i) transpose_item(p, NG * 7 + (c - NG) * 11 + i); }
    } else {
        for (int item = blockIdx.x; item < NG + NTL; item += gridDim.x) { if (item < NG) gemv_item(p, item, lds); else transpose_item(p, item - NG); }
    }
}

__device__ __forceinline__ void phase1(const Params& p) {
    const int tid = threadIdx.x, wid = tid >> 6, lane = tid & 63;
    const int gw = blockIdx.x * 8 + wid, nw = gridDim.x * 8;
    for (int r0 = gw * 8; r0 < NTOK; r0 += nw * 8) {
        const int b = r0 >> 11; const float* md = p.mod + b * 6144;
        f32x4 gs[8], sh[8];
#pragma unroll
        for (int i = 0; i < 8; ++i) { const int c = i * 256 + lane * 4; const f32x4 g = *(const f32x4*)(p.g_pre + c), sc = *(const f32x4*)(md + 2048 + c);
            sh[i] = *(const f32x4*)(md + c); gs[i] = g * (1.0f + sc); }
        for (int j = 0; j < 8; ++j) { const size_t row = (size_t)(r0 + j); f32x4 xv[8]; float ss = 0.f;
#pragma unroll
            for (int i = 0; i < 8; ++i) { xv[i] = __builtin_nontemporal_load((const f32x4*)(p.x + row * DM + i * 256 + lane * 4)); ss += xv[i][0] * xv[i][0] + xv[i][1] * xv[i][1] + xv[i][2] * xv[i][2] + xv[i][3] * xv[i][3]; }
#pragma unroll
            for (int o = 1; o < 64; o <<= 1) ss += __shfl_xor(ss, o);
            const float rstd = rsqrtf(ss * (1.0f / DM) + EPSV);
#pragma unroll
            for (int i = 0; i < 8; ++i) { const f32x4 hv = xv[i] * rstd * gs[i] + sh[i];
                u32x2 w; w.x = cvt_pk_bf16(hv[0], hv[1]); w.y = cvt_pk_bf16(hv[2], hv[3]);
                *(u32x2*)(p.hy + row * DM + i * 256 + lane * 4) = w; } }
    }
}

constexpr int IMG_BYTES = 41472;
__device__ __forceinline__ void phase3a(const Params& p, unsigned char* lds) {
    const int tid = threadIdx.x, wid = __builtin_amdgcn_readfirstlane(tid >> 6), lane = tid & 63, l15 = lane & 15, q4 = lane >> 4;
    constexpr int RSD = 272;
    unsigned char* QR = lds;
    unsigned char* KR = QR + 17408;
    float* SEG = (float*)(KR + 17408);
    const int d0 = 2 * lane;
    auto map_ch = [&](int ch0) { return (gridDim.x == 256) ? ((ch0 & 7) * 256 + (ch0 >> 8) * 32 + ((ch0 >> 3) & 31)) : ch0; };
    auto load_in = [&](int ch, unsigned (&ff)[8], unsigned (&qq)[8]) __attribute__((always_inline)) {
        const int b = ch >> 8, n = (ch >> 3) & 31, h = ch & 7;
        const bf16_t* base = p.proj + (size_t)(b * SEQ + n * 64 + wid * 8) * 8192 + h * 128 + d0;
#pragma unroll
        for (int i = 0; i < 8; ++i) { ff[i] = __builtin_nontemporal_load((const unsigned*)(base + 1024 + (size_t)i * 8192)); qq[i] = __builtin_nontemporal_load((const unsigned*)(base + (size_t)i * 8192)); }
    };
    auto item_body = [&](int ch, const unsigned (&ff)[8], const unsigned (&qq)[8]) __attribute__((always_inline)) {
        const int h = ch & 7;
        float lb0, lb1;
        { const float l00 = p.lb_logits[h * 128 + d0], l01 = p.lb_logits[h * 128 + d0 + 1], l10 = p.lb_logits[1024 + h * 128 + d0], l11 = p.lb_logits[1024 + h * 128 + d0 + 1];
          lb0 = 1.0f / (1.0f + expf(l10 - l00)); lb1 = 1.0f / (1.0f + expf(l11 - l01)); }
        const float om0 = 1.0f - lb0, om1 = 1.0f - lb1;
        unsigned char* img = p.img + (size_t)ch * IMG_BYTES;
        float cp[8][2], kk[8][2], qv[8][2];
        float run0 = 1.f, run1 = 1.f;
#pragma unroll
        for (int i = 0; i < 8; ++i) {
            const float s0 = sigmoidf_(bflo(ff[i])), s1 = sigmoidf_(bfhi(ff[i]));
            const float f0 = lb0 + om0 * s0, f1 = lb1 + om1 * s1;
            run0 *= f0; run1 *= f1; cp[i][0] = run0; cp[i][1] = run1;
            kk[i][0] = 1.0f - f0; kk[i][1] = 1.0f - f1;
            qv[i][0] = bflo(qq[i]); qv[i][1] = bfhi(qq[i]); }
        *(f32x2*)(SEG + wid * 128 + d0) = (f32x2){run0, run1};
        __syncthreads();
        float pre0 = 1.f, pre1 = 1.f, mid0 = 1.f, mid1 = 1.f, las0 = 1.f, las1 = 1.f;
#pragma unroll
        for (int w = 0; w < 8; ++w) { const f32x2 sg = *(const f32x2*)(SEG + w * 128 + d0);
            if (w < wid) { pre0 *= sg.x; pre1 *= sg.y; } if (w < 4) { mid0 *= sg.x; mid1 *= sg.y; } las0 *= sg.x; las1 *= sg.y; }
        const float rmid0 = __builtin_amdgcn_rcpf(mid0), rmid1 = __builtin_amdgcn_rcpf(mid1);
        unsigned klt0[4], klt1[4];
#pragma unroll
        for (int i = 0; i < 8; i += 2) {
            float kl[2][2];
#pragma unroll
            for (int ii = 0; ii < 2; ++ii) {
                const float P0 = fmaxf(pre0 * cp[i + ii][0], 1e-30f), P1 = fmaxf(pre1 * cp[i + ii][1], 1e-30f);
                const float rP0 = __builtin_amdgcn_rcpf(P0), rP1 = __builtin_amdgcn_rcpf(P1);
                const float qb0 = qv[i + ii][0] * P0, qb1 = qv[i + ii][1] * P1;
                const float kp0 = kk[i + ii][0] * rP0, kp1 = kk[i + ii][1] * rP1;
                kl[ii][0] = kp0 * las0; kl[ii][1] = kp1 * las1;
                const int t = wid * 8 + i + ii;
                *(unsigned*)(QR + t * RSD + d0 * 2) = cvt_pk_bf16(qb0 * rmid0, qb1 * rmid1);
                *(unsigned*)(KR + t * RSD + d0 * 2) = cvt_pk_bf16(kp0 * mid0, kp1 * mid1);
                *(unsigned*)(img + t * 256 + d0 * 2) = cvt_pk_bf16(qb0, qb1);
            }
            klt0[i >> 1] = cvt_pk_bf16(kl[0][0], kl[1][0]); klt1[i >> 1] = cvt_pk_bf16(kl[0][1], kl[1][1]);
        }
        *(u32x4*)(img + 16384 + d0 * 128 + wid * 16) = (u32x4){klt0[0], klt0[1], klt0[2], klt0[3]};
        *(u32x4*)(img + 16384 + (d0 + 1) * 128 + wid * 16) = (u32x4){klt1[0], klt1[1], klt1[2], klt1[3]};
        if (wid == 0) *(f32x2*)(img + 40960 + d0 * 4) = (f32x2){las0, las1};
        __syncthreads();
        const int tt = wid >> 1;
#pragma unroll
        for (int s2 = 0; s2 < 2; ++s2) { const int st = (wid & 1) * 2 + s2;
            f32x4 pacc = (f32x4){0.f, 0.f, 0.f, 0.f};
            if (st <= tt) {
#pragma unroll
                for (int ks = 0; ks < 4; ++ks) { const bf16x8 a = *(const bf16x8*)(KR + (st * 16 + l15) * RSD + (ks * 32 + q4 * 8) * 2), bb = *(const bf16x8*)(QR + (tt * 16 + l15) * RSD + (ks * 32 + q4 * 8) * 2);
                    pacc = __builtin_amdgcn_mfma_f32_16x16x32_bf16(a, bb, pacc, 0, 0, 0); } }
            const int t = tt * 16 + l15, sb = st * 16 + q4 * 4;
            const float v0 = (sb + 0 <= t) ? pacc[0] : 0.f, v1 = (sb + 1 <= t) ? pacc[1] : 0.f, v2 = (sb + 2 <= t) ? pacc[2] : 0.f, v3 = (sb + 3 <= t) ? pacc[3] : 0.f;
            u32x2 w; w.x = cvt_pk_bf16(v0, v1); w.y = cvt_pk_bf16(v2, v3);
            *(u32x2*)(img + 32768 + t * 128 + sb * 2) = w; }
    };
    if (gridDim.x == 256) {
        unsigned fa[8], qa[8], fb[8], qb[8];
        load_in(map_ch(blockIdx.x), fa, qa);
#pragma unroll
        for (int k = 0; k < 8; k += 2) {
            load_in(map_ch(blockIdx.x + (k + 1) * 256), fb, qb);
            item_body(map_ch(blockIdx.x + k * 256), fa, qa);
            if (k + 2 < 8) load_in(map_ch(blockIdx.x + (k + 2) * 256), fa, qa);
            item_body(map_ch(blockIdx.x + (k + 1) * 256), fb, qb);
        }
    } else {
        for (int ch0 = blockIdx.x; ch0 < 2048; ch0 += gridDim.x) { unsigned fa[8], qa[8]; load_in(ch0, fa, qa); item_body(ch0, fa, qa); }
    }
}
__device__ __forceinline__ void phase3s(const Params& p, unsigned char* lds) {
    const int tid = threadIdx.x, wid = __builtin_amdgcn_readfirstlane(tid >> 6), lane = tid & 63, l15 = lane & 15, q4 = lane >> 4;
    constexpr int RSD = 272, RSS = 144, IMGL = 49664;
    unsigned char* ST = lds + 2 * IMGL;
    for (int item0 = blockIdx.x; item0 < 256; item0 += gridDim.x) {
        const int item = (gridDim.x == 256) ? ((((item0 & 7) * 8 + (item0 >> 5)) << 2) | ((item0 >> 3) & 3)) : item0;
        const int b = item >> 5, h = (item >> 2) & 7, vs = item & 3;
        const bf16_t* vp = p.proj + (size_t)(b * SEQ) * 8192 + 2048 + h * 128 + vs * 32 + (tid & 7) * 4 + (size_t)(tid >> 3) * 8192;
        const unsigned char* img0 = p.img + (size_t)((b * 32) * 8 + h) * IMG_BYTES;
        for (int i = tid; i < 2 * 8704 / 4; i += 512) ((unsigned*)ST)[i] = 0u;
        f32x4 sacc[4];
#pragma unroll
        for (int i = 0; i < 4; ++i) sacc[i] = (f32x4){0.f, 0.f, 0.f, 0.f};
        u32x4 rq0[3], rq1[3], rk0[3], rk1[3], rp[3]; f32x4 rdec0[3], rdec1[3]; u32x2 rv[3];
        const int wd = (wid & 3) * 2;
#define P3S_LOAD(S, nn) do { const unsigned char* im = img0 + (size_t)(nn) * 8 * IMG_BYTES; \
            rq0[S] = *(const u32x4*)(im + tid * 16); rq1[S] = *(const u32x4*)(im + 8192 + tid * 16); \
            rk0[S] = *(const u32x4*)(im + 16384 + tid * 16); rk1[S] = *(const u32x4*)(im + 24576 + tid * 16); \
            rp[S] = *(const u32x4*)(im + 32768 + tid * 16); \
            rdec0[S] = *(const f32x4*)(im + 40960 + (16 * wd + q4 * 4) * 4); rdec1[S] = *(const f32x4*)(im + 40960 + (16 * wd + 16 + q4 * 4) * 4); \
            rv[S] = __builtin_nontemporal_load((const u32x2*)(vp + (size_t)(nn) * 64 * 8192)); } while (0)
#define P3S_PUT(S, nn) do { unsigned char* B_ = lds + ((nn) & 1) * IMGL; \
            u32x4 q0 = rq0[S], q1 = rq1[S], k0 = rk0[S], k1 = rk1[S], pm = rp[S]; unsigned vx = rv[S].x, vy = rv[S].y; \
            asm volatile("" : "+v"(q0), "+v"(q1), "+v"(k0), "+v"(k1), "+v"(pm), "+v"(vx), "+v"(vy)); \
            const int pa = tid, pb = tid + 512; \
            *(u32x4*)(B_ + (pa >> 4) * RSD + (pa & 15) * 16) = q0; *(u32x4*)(B_ + (pb >> 4) * RSD + (pb & 15) * 16) = q1; \
            *(u32x4*)(B_ + 17408 + (pa >> 3) * RSS + (pa & 7) * 16) = k0; *(u32x4*)(B_ + 17408 + (pb >> 3) * RSS + (pb & 7) * 16) = k1; \
            *(u32x4*)(B_ + 35840 + (pa >> 3) * RSS + (pa & 7) * 16) = pm; \
            const int t = tid >> 3, v4 = (tid & 7) * 4; \
            *(bf16_t*)(B_ + 45056 + (v4 + 0) * RSS + t * 2) = (bf16_t)(vx & 0xffff); *(bf16_t*)(B_ + 45056 + (v4 + 1) * RSS + t * 2) = (bf16_t)(vx >> 16); \
            *(bf16_t*)(B_ + 45056 + (v4 + 2) * RSS + t * 2) = (bf16_t)(vy & 0xffff); *(bf16_t*)(B_ + 45056 + (v4 + 3) * RSS + t * 2) = (bf16_t)(vy >> 16); } while (0)
#define P3S_STEP(S1, n) do { \
            f32x4 dcur0 = rdec0[(n) % 3], dcur1 = rdec1[(n) % 3]; asm volatile("" : "+v"(dcur0), "+v"(dcur1)); \
            if ((n) + 1 < 32) P3S_PUT(S1, (n) + 1);                       \
            asm volatile("" ::: "memory"); \
            if ((n) + 3 < 32) P3S_LOAD((n) % 3, (n) + 3);                \
            asm volatile("" ::: "memory"); \
            const unsigned char* B_ = lds + ((n) & 1) * IMGL; const unsigned char* QB = B_; const unsigned char* KLT = B_ + 17408; const unsigned char* PM = B_ + 35840; const unsigned char* VT = B_ + 45056; \
            const unsigned char* STc = ST + ((n) & 1) * 8704; unsigned char* STn = ST + (((n) + 1) & 1) * 8704; \
            if (wid < 4) { const int tt = wid; \
                f32x4 oa0 = (f32x4){0.f, 0.f, 0.f, 0.f}, oa1 = (f32x4){0.f, 0.f, 0.f, 0.f}; \
                _Pragma("unroll") for (int ks = 0; ks < 4; ++ks) { const bf16x8 bb = *(const bf16x8*)(QB + (tt * 16 + l15) * RSD + (ks * 32 + q4 * 8) * 2); \
                    const bf16x8 a0 = *(const bf16x8*)(STc + (l15) * RSD + (ks * 32 + q4 * 8) * 2), a1 = *(const bf16x8*)(STc + (16 + l15) * RSD + (ks * 32 + q4 * 8) * 2); \
                    oa0 = __builtin_amdgcn_mfma_f32_16x16x32_bf16(a0, bb, oa0, 0, 0, 0); oa1 = __builtin_amdgcn_mfma_f32_16x16x32_bf16(a1, bb, oa1, 0, 0, 0); } \
                _Pragma("unroll") for (int ks = 0; ks < 2; ++ks) { const bf16x8 bb = *(const bf16x8*)(PM + (tt * 16 + l15) * RSS + (ks * 32 + q4 * 8) * 2); \
                    const bf16x8 a0 = *(const bf16x8*)(VT + (l15) * RSS + (ks * 32 + q4 * 8) * 2), a1 = *(const bf16x8*)(VT + (16 + l15) * RSS + (ks * 32 + q4 * 8) * 2); \
                    oa0 = __builtin_amdgcn_mfma_f32_16x16x32_bf16(a0, bb, oa0, 0, 0, 0); oa1 = __builtin_amdgcn_mfma_f32_16x16x32_bf16(a1, bb, oa1, 0, 0, 0); } \
                const size_t row = (size_t)(b * SEQ + (n) * 64 + tt * 16 + l15); const int col = h * 128 + vs * 32 + q4 * 4; \
                u32x2 w0, w1; w0.x = cvt_pk_bf16(oa0[0], oa0[1]); w0.y = cvt_pk_bf16(oa0[2], oa0[3]); w1.x = cvt_pk_bf16(oa1[0], oa1[1]); w1.y = cvt_pk_bf16(oa1[2], oa1[3]); \
                *(u32x2*)(p.o + row * 1024 + col) = w0; *(u32x2*)(p.o + row * 1024 + col + 16) = w1; \
                float s0 = oa0[0] * oa0[0] + oa0[1] * oa0[1] + oa0[2] * oa0[2] + oa0[3] * oa0[3], s1 = oa1[0] * oa1[0] + oa1[1] * oa1[1] + oa1[2] * oa1[2] + oa1[3] * oa1[3]; \
                s0 += __shfl_xor(s0, 16); s0 += __shfl_xor(s0, 32); s1 += __shfl_xor(s1, 16); s1 += __shfl_xor(s1, 32); \
                if (q4 == 0) *(f32x2*)(p.ssq_h + row * 64 + h * 8 + vs * 2) = (f32x2){s0, s1}; \
            } else { \
                sacc[0] *= dcur0; sacc[1] *= dcur0; sacc[2] *= dcur1; sacc[3] *= dcur1; \
                _Pragma("unroll") for (int ks = 0; ks < 2; ++ks) { \
                    const bf16x8 a0 = *(const bf16x8*)(KLT + (16 * wd + l15) * RSS + (ks * 32 + q4 * 8) * 2), a1 = *(const bf16x8*)(KLT + (16 * wd + 16 + l15) * RSS + (ks * 32 + q4 * 8) * 2); \
                    const bf16x8 b0 = *(const bf16x8*)(VT + (l15) * RSS + (ks * 32 + q4 * 8) * 2), b1 = *(const bf16x8*)(VT + (16 + l15) * RSS + (ks * 32 + q4 * 8) * 2); \
                    sacc[0] = __builtin_amdgcn_mfma_f32_16x16x32_bf16(a0, b0, sacc[0], 0, 0, 0); sacc[1] = __builtin_amdgcn_mfma_f32_16x16x32_bf16(a0, b1, sacc[1], 0, 0, 0); \
                    sacc[2] = __builtin_amdgcn_mfma_f32_16x16x32_bf16(a1, b0, sacc[2], 0, 0, 0); sacc[3] = __builtin_amdgcn_mfma_f32_16x16x32_bf16(a1, b1, sacc[3], 0, 0, 0); } \
                _Pragma("unroll") for (int i = 0; i < 4; ++i) { const int dt = wd + (i >> 1), v2 = i & 1; \
                    u32x2 w; w.x = cvt_pk_bf16(sacc[i][0], sacc[i][1]); w.y = cvt_pk_bf16(sacc[i][2], sacc[i][3]); \
                    *(u32x2*)(STn + (v2 * 16 + l15) * RSD + (16 * dt + q4 * 4) * 2) = w; } \
            } \
            __syncthreads(); } while (0)
        P3S_LOAD(0, 0); P3S_LOAD(1, 1); P3S_LOAD(2, 2);
        P3S_PUT(0, 0);
        __syncthreads();
        _Pragma("unroll") for (int n = 0; n < 32; ++n) { P3S_STEP((n + 1) % 3, n); }
#undef P3S_STEP
#undef P3S_PUT
#undef P3S_LOAD
    }
}

__device__ __forceinline__ void phase3b(const Params& p) {
    const int T = gridDim.x * 512, g = blockIdx.x * 512 + threadIdx.x;
    for (int e = g; e < NTOK * 128; e += T) {
        const size_t r = (size_t)(e >> 7); const int cgp = e & 127, h = cgp >> 4, v0 = (cgp & 15) * 8;
        const u32x4 o8 = __builtin_nontemporal_load((const u32x4*)(p.o + r * 1024 + cgp * 8)), z8 = __builtin_nontemporal_load((const u32x4*)(p.proj + r * 8192 + 3072 + cgp * 8));
        const f32x4 s0 = *(const f32x4*)(p.ssq_h + r * 64 + h * 8), s1 = *(const f32x4*)(p.ssq_h + r * 64 + h * 8 + 4);
        const float ss = (s0[0] + s0[1]) + (s0[2] + s0[3]) + (s1[0] + s1[1]) + (s1[2] + s1[3]);
        const float rstd = rsqrtf(ss * (1.0f / 128.0f) + EPSV);
        const f32x4 g0 = *(const f32x4*)(p.g_head + v0), g1 = *(const f32x4*)(p.g_head + v0 + 4);
        u32x4 w;
        w.x = cvt_pk_bf16(bflo(o8.x) * rstd * g0[0] * siluf_(bflo(z8.x)), bfhi(o8.x) * rstd * g0[1] * siluf_(bfhi(z8.x)));
        w.y = cvt_pk_bf16(bflo(o8.y) * rstd * g0[2] * siluf_(bflo(z8.y)), bfhi(o8.y) * rstd * g0[3] * siluf_(bfhi(z8.y)));
        w.z = cvt_pk_bf16(bflo(o8.z) * rstd * g1[0] * siluf_(bflo(z8.z)), bfhi(o8.z) * rstd * g1[1] * siluf_(bfhi(z8.z)));
        w.w = cvt_pk_bf16(bflo(o8.w) * rstd * g1[2] * siluf_(bflo(z8.w)), bfhi(o8.w) * rstd * g1[3] * siluf_(bfhi(z8.w)));
        *(u32x4*)(p.hy + r * 2048 + cgp * 8) = w;
    }
    for (int e = g; e < (NTOK / 16) * 128; e += T) {
        const int rb = e >> 7, cgp = e & 127, c0 = cgp * 8;
        const size_t r0 = (size_t)rb * 16; const int t0 = (int)(r0 & (SEQ - 1));
        float w0[8], w1[8], w2[8], bs[8], u1[8], u2[8];
#pragma unroll
        for (int j = 0; j < 8; ++j) { w0[j] = p.conv_w[c0 + j]; w1[j] = p.conv_w[1024 + c0 + j]; w2[j] = p.conv_w[2048 + c0 + j]; bs[j] = p.conv_b[c0 + j]; u1[j] = 0.f; u2[j] = 0.f; }
        if (t0 > 0) {
            const u32x4 ga = *(const u32x4*)(p.proj + (r0 - 1) * 8192 + 5120 + c0), va = *(const u32x4*)(p.proj + (r0 - 1) * 8192 + 6144 + c0);
            const u32x4 gb = *(const u32x4*)(p.proj + (r0 - 2) * 8192 + 5120 + c0), vb = *(const u32x4*)(p.proj + (r0 - 2) * 8192 + 6144 + c0);
            u1[0] = bflo(ga.x) * bflo(va.x); u1[1] = bfhi(ga.x) * bfhi(va.x); u1[2] = bflo(ga.y) * bflo(va.y); u1[3] = bfhi(ga.y) * bfhi(va.y);
            u1[4] = bflo(ga.z) * bflo(va.z); u1[5] = bfhi(ga.z) * bfhi(va.z); u1[6] = bflo(ga.w) * bflo(va.w); u1[7] = bfhi(ga.w) * bfhi(va.w);
            u2[0] = bflo(gb.x) * bflo(vb.x); u2[1] = bfhi(gb.x) * bfhi(vb.x); u2[2] = bflo(gb.y) * bflo(vb.y); u2[3] = bfhi(gb.y) * bfhi(vb.y);
            u2[4] = bflo(gb.z) * bflo(vb.z); u2[5] = bfhi(gb.z) * bfhi(vb.z); u2[6] = bflo(gb.w) * bflo(vb.w); u2[7] = bfhi(gb.w) * bfhi(vb.w);
        }
#pragma unroll 4
        for (int i = 0; i < 16; ++i) {
            const bf16_t* rp = p.proj + (r0 + i) * 8192 + c0;
            const u32x4 gbb = __builtin_nontemporal_load((const u32x4*)(rp + 4096)), gcc = __builtin_nontemporal_load((const u32x4*)(rp + 5120)), vbb = __builtin_nontemporal_load((const u32x4*)(rp + 6144)), zb = __builtin_nontemporal_load((const u32x4*)(rp + 7168));
            float u[8], gv[8], zv[8], y[8];
            u[0] = bflo(gcc.x) * bflo(vbb.x); u[1] = bfhi(gcc.x) * bfhi(vbb.x); u[2] = bflo(gcc.y) * bflo(vbb.y); u[3] = bfhi(gcc.y) * bfhi(vbb.y);
            u[4] = bflo(gcc.z) * bflo(vbb.z); u[5] = bfhi(gcc.z) * bfhi(vbb.z); u[6] = bflo(gcc.w) * bflo(vbb.w); u[7] = bfhi(gcc.w) * bfhi(vbb.w);
            gv[0] = bflo(gbb.x); gv[1] = bfhi(gbb.x); gv[2] = bflo(gbb.y); gv[3] = bfhi(gbb.y); gv[4] = bflo(gbb.z); gv[5] = bfhi(gbb.z); gv[6] = bflo(gbb.w); gv[7] = bfhi(gbb.w);
            zv[0] = bflo(zb.x); zv[1] = bfhi(zb.x); zv[2] = bflo(zb.y); zv[3] = bfhi(zb.y); zv[4] = bflo(zb.z); zv[5] = bfhi(zb.z); zv[6] = bflo(zb.w); zv[7] = bfhi(zb.w);
#pragma unroll
            for (int j = 0; j < 8; ++j) { const float cv = bs[j] + w0[j] * u2[j] + w1[j] * u1[j] + w2[j] * u[j]; y[j] = gv[j] * cv * siluf_(zv[j]); u2[j] = u1[j]; u1[j] = u[j]; }
            u32x4 w; w.x = cvt_pk_bf16(y[0], y[1]); w.y = cvt_pk_bf16(y[2], y[3]); w.z = cvt_pk_bf16(y[4], y[5]); w.w = cvt_pk_bf16(y[6], y[7]);
            *(u32x4*)(p.hy + (r0 + i) * 2048 + 1024 + c0) = w;
        }
    }
}

__device__ __forceinline__ void phase6(const Params& p, const float dscale) {
    const int tid = threadIdx.x, wid = tid >> 6, lane = tid & 63;
    const int gw = blockIdx.x * 8 + wid, nw = gridDim.x * 8;
    for (int rowi = gw; rowi < NTOK; rowi += nw) {
        const size_t row = (size_t)rowi; const int b = rowi >> 11;
        float ss = (lane < 32) ? p.ssq_o[row * 32 + lane] : 0.f;
#pragma unroll
        for (int o = 1; o < 64; o <<= 1) ss += __shfl_xor(ss, o);
        const float rstd = rsqrtf(ss * (1.0f / DM) + EPSV);
#pragma unroll
        for (int i = 0; i < 8; ++i) { const int c = i * 256 + lane * 4;
            const f32x4 xv = __builtin_nontemporal_load((const f32x4*)(p.x + row * DM + c)), gt = *(const f32x4*)(p.mod + b * 6144 + 4096 + c), gp = *(const f32x4*)(p.g_post + c);
            const u32x2 ov = __builtin_nontemporal_load((const u32x2*)(p.outpre + row * DM + c));
            f32x4 r;
            r[0] = xv[0] + gt[0] * (bflo(ov.x) * rstd * gp[0]); r[1] = xv[1] + gt[1] * (bfhi(ov.x) * rstd * gp[1]);
            r[2] = xv[2] + gt[2] * (bflo(ov.y) * rstd * gp[2]); r[3] = xv[3] + gt[3] * (bfhi(ov.y) * rstd * gp[3]);
            __builtin_nontemporal_store(r * dscale, (f32x4*)(p.out + row * DM + c)); }
    }
}


#ifndef DIAG
#define DIAG 0
#endif
__device__ __forceinline__ void chk_sum(const void* buf, size_t bytes, unsigned long long* slot) {
    const u32x4* q = (const u32x4*)buf; const size_t n = bytes / 16; unsigned long long s = 0ull;
    for (size_t i = (size_t)blockIdx.x * 512 + threadIdx.x; i < n; i += (size_t)gridDim.x * 512) { const u32x4 v = q[i]; s += (unsigned long long)v.x + 3ull * v.y + 5ull * v.z + 7ull * v.w; }
    for (int o = 32; o; o >>= 1) s += __shfl_xor(s, o);
    if ((threadIdx.x & 63) == 0) atomicAdd(slot, s);
}
#define XB_TMO      128
#define XB_XCNT(j)  (256  + 64 * (j))
#define XB_XSUB(j)  (1280 + 64 * (j))
#define XB_XGEN(j)  (2304 + 64 * (j))
#define XB_TOP      3328
#define XB_TOPGEN   3392
#define XCD_BAR_WORDS 3456
#define XB_SPIN_CAP (1u << 22)
__device__ __forceinline__ unsigned xb_ld(unsigned* p)              { return __hip_atomic_load(p, __ATOMIC_RELAXED, __HIP_MEMORY_SCOPE_AGENT); }
__device__ __forceinline__ unsigned xb_add(unsigned* p, unsigned v) { return __hip_atomic_fetch_add(p, v, __ATOMIC_RELAXED, __HIP_MEMORY_SCOPE_AGENT); }
__device__ __forceinline__ unsigned xb_xcc_id() { return (unsigned)__builtin_amdgcn_s_getreg((3 << 11) | 20) & 0xFu; }
#define XB_SPIN(cond, bar) do { unsigned _sp = 0; while (cond) { __builtin_amdgcn_s_sleep(1); \
    if ((++_sp & 255u) == 0u) { if (xb_ld(&(bar)[XB_TMO])) break; if (_sp > XB_SPIN_CAP) { atomicAdd(&(bar)[XB_TMO], 1u); break; } } } } while (0)
struct XcdBarrier { unsigned* bar; unsigned x; volatile LAS unsigned* st; };
__device__ __forceinline__ XcdBarrier xcd_barrier_post(unsigned* bar, volatile LAS unsigned* st) {
    XcdBarrier b; b.bar = bar; b.x = xb_xcc_id(); b.st = st;
    if (threadIdx.x == 0) (void)xb_add(&bar[XB_XCNT(b.x)], 1u);
    return b;
}
__device__ __forceinline__ void xcd_barrier_complete(unsigned* bar, unsigned x, unsigned& nloc, unsigned& nx) {
    const unsigned G = gridDim.x * gridDim.y * gridDim.z;
    unsigned sum, cnt, mine, sp = 0u;
    for (;;) {
        sum = 0u; cnt = 0u; mine = 0u;
#pragma unroll
        for (unsigned j = 0; j < 16; ++j) { const unsigned c = xb_ld(&bar[XB_XCNT(j)]); sum += c; cnt += (c > 0u) ? 1u : 0u; mine = (j == x) ? c : mine; }
        if (sum == G) break;
        __builtin_amdgcn_s_sleep(1);
        if ((++sp & 255u) == 0u) { if (xb_ld(&bar[XB_TMO])) break; if (sp > XB_SPIN_CAP) { atomicAdd(&bar[XB_TMO], 1u); break; } }
    }
    nloc = mine > 0u ? mine : 1u; nx = cnt > 0u ? cnt : 1u;
}
__device__ __forceinline__ void xcd_barrier(const XcdBarrier& b) {
    asm volatile("s_waitcnt vmcnt(0)" ::: "memory");
    __syncthreads();
    if (threadIdx.x == 0) {
        unsigned* bar = b.bar;
        __builtin_amdgcn_s_waitcnt(0);
        unsigned nloc = b.st[0], nx = b.st[1];
        if (nloc == 0u) { xcd_barrier_complete(bar, b.x, nloc, nx); b.st[0] = nloc; b.st[1] = nx; }
        const unsigned old = xb_add(&bar[XB_XSUB(b.x)], 1u);
        const unsigned gen = old / nloc;
        if (old + 1u == (gen + 1u) * nloc) {
            __builtin_amdgcn_fence(__ATOMIC_RELEASE, "agent");
            asm volatile("s_waitcnt vmcnt(0)" ::: "memory");
            const unsigned og = xb_add(&bar[XB_TOP], 1u);
            const unsigned tg = og / nx;
            if (og + 1u == (tg + 1u) * nx) xb_add(&bar[XB_TOPGEN], 1u);
            else XB_SPIN(xb_ld(&bar[XB_TOPGEN]) == tg, bar);
            __builtin_amdgcn_fence(__ATOMIC_ACQUIRE, "agent");
            xb_add(&bar[XB_XGEN(b.x)], 1u);
            asm volatile("s_waitcnt vmcnt(0)" ::: "memory");
        } else {
            XB_SPIN(xb_ld(&bar[XB_XGEN(b.x)]) == gen, bar);
            __builtin_amdgcn_fence(__ATOMIC_ACQUIRE, "agent");
            asm volatile("s_waitcnt vmcnt(0)" ::: "memory");
        }
    }
    __syncthreads();
}
__device__ __forceinline__ void gsync(cg::grid_group& grid) {
    __builtin_amdgcn_fence(__ATOMIC_RELEASE, "agent");
    asm volatile("s_waitcnt vmcnt(0) lgkmcnt(0)" ::: "memory");
    grid.sync();
    __builtin_amdgcn_fence(__ATOMIC_ACQUIRE, "agent");
    asm volatile("s_waitcnt vmcnt(0)" ::: "memory");
    __syncthreads();
}
__global__ void __launch_bounds__(512, 2) mega(Params p) {
    extern __shared__ __attribute__((aligned(16))) unsigned char shm[];
    cg::grid_group grid = cg::this_grid();
    const bool multi = (p.ph_hi - p.ph_lo) > 1;
    if (p.ph_lo < 0) gsync(grid);
    volatile LAS unsigned* xst = (volatile LAS unsigned*)((LAS unsigned char*)shm + 131072);
    if (threadIdx.x == 0) { xst[0] = 0u; xst[1] = 0u; }
    __syncthreads();
    XcdBarrier xb; xb.bar = p.bar; xb.x = 0; xb.st = xst;
    if (multi) xb = xcd_barrier_post(p.bar, xst);
#define PH(n) if (p.ph_lo <= (n) && (n) < p.ph_hi)
#define GS(n) if (multi && p.ph_lo <= (n) && (n) + 1 < p.ph_hi) xcd_barrier(xb)
    PH(0) phase0(p, shm);
    GS(0);
    PH(1) phase1(p);
    GS(1);
#if DIAG
    if (multi) chk_sum(p.hy, (size_t)NTOK * 2048 * 2, p.chk + 2);
#endif
    PH(2) { pg8::StaticOrder S; S.init(NTOK, 12288, (int)gridDim.x, (int)blockIdx.x, 32); pg8::Gemm g{p.hy, p.wt1, NTOK, 12288, 2048}; EpiG1 E{p.proj, p.merge, p.b_merge, p.chk};
      pg8::gemm_phase<EpiG1>((LAS unsigned char*)shm, g, S, E); }
    GS(2);
#if DIAG
    if (multi) chk_sum(p.proj, (size_t)NTOK * 8192 * 2, p.chk + 3);
#endif
    PH(3) { phase3a(p, shm); if (multi) xcd_barrier(xb); phase3s(p, shm); }
    GS(3);
    PH(4) phase3b(p);
    GS(4);
    PH(5) { pg8::StaticOrder S; S.init(NTOK, 2048, (int)gridDim.x, (int)blockIdx.x); pg8::Gemm g{p.hy, p.wt2, NTOK, 2048, 2048}; EpiG2 E{p.merge, p.mix, (bf16_t*)p.tmp};
      pg8::gemm_phase<EpiG2>((LAS unsigned char*)shm, g, S, E); }
    GS(5);
    PH(6) { pg8::StaticOrder S; S.init(NTOK, 2048, (int)gridDim.x, (int)blockIdx.x); pg8::Gemm g{p.mix, p.wt3, NTOK, 2048, 2048}; EpiG3 E{p.outpre, p.ssq_o};
      pg8::gemm_phase<EpiG3>((LAS unsigned char*)shm, g, S, E); }
    GS(6);
#if DIAG
    float dscale = 1.0f;
    if (multi) {
        chk_sum(p.wt1, (size_t)(12288 + 2048 + 2048) * 2048 * 2, p.chk + 0);
        chk_sum(p.mod, (size_t)8 * 6144 * 4, p.chk + 1);
        chk_sum(p.o, (size_t)NTOK * 1024 * 2, p.chk + 5);
        chk_sum(p.ssq_h, (size_t)NTOK * 64 * 4, p.chk + 6);
        chk_sum(p.hy, (size_t)NTOK * 2048 * 2, p.chk + 7);
        chk_sum(p.mix, (size_t)NTOK * 2048 * 2, p.chk + 8);
        chk_sum(p.outpre, (size_t)NTOK * 2048 * 2, p.chk + 9);
        chk_sum(p.ssq_o, (size_t)NTOK * 32 * 4, p.chk + 10);
        chk_sum(p.merge, (size_t)NTOK * 4096 * 2, p.chk + 4);
        chk_sum(p.b_merge, (size_t)4096 * 4, p.chk + 13);
        gsync(grid);
        if (blockIdx.x == 0 && threadIdx.x == 0) {
            unsigned long long m = 0ull;
            if (p.chk[31] == 0x1234567887654321ull && p.chk[14] != p.chk[16 + 14]) m = 14ull;
            else if (p.chk[31] == 0x1234567887654321ull) { for (int k = 0; k < 11; ++k) if (p.chk[k] != p.chk[16 + k]) { m = (unsigned long long)(k + 1); break; } }
            for (int k = 0; k < 15; ++k) p.chk[16 + k] = p.chk[k];
            p.chk[31] = 0x1234567887654321ull; p.chk[32] = m;
        }
        gsync(grid);
        dscale = 1.0f + 0.2f * (float)__hip_atomic_load(p.chk + 32, __ATOMIC_RELAXED, __HIP_MEMORY_SCOPE_AGENT);
    }
    PH(7) phase6(p, dscale);
#else
    PH(7) phase6(p, 1.0f);
#endif
#undef PH
#undef GS
}

extern "C" void kernel_launch(void* const* d_in, const int* in_sizes, int n_in, void* d_out, int out_size, void* d_ws, size_t ws_size, hipStream_t stream) {
    (void)in_sizes; (void)n_in; (void)out_size;
    Params p{};
    p.x = (const float*)d_in[0]; p.c = (const float*)d_in[1]; p.w_ada = (const float*)d_in[2]; p.b_ada = (const float*)d_in[3]; p.g_pre = (const float*)d_in[4];
    p.w_in = (const float*)d_in[5]; p.lb_logits = (const float*)d_in[6]; p.g_head = (const float*)d_in[7]; p.conv_w = (const float*)d_in[8]; p.conv_b = (const float*)d_in[9];
    p.w_up_a = (const float*)d_in[10]; p.w_up_b = (const float*)d_in[11]; p.w_merge = (const float*)d_in[12]; p.b_merge = (const float*)d_in[13]; p.w_o = (const float*)d_in[14]; p.g_post = (const float*)d_in[15];
    p.out = (float*)d_out;
    unsigned char* ws = (unsigned char*)d_ws; size_t off = 0;
    auto take = [&](size_t bytes) { unsigned char* r = ws + off; off += (bytes + 255) & ~(size_t)255; return r; };
    p.wt1 = (bf16_t*)take((size_t)12288 * 2048 * 2);
    p.wt2 = (bf16_t*)take((size_t)2048 * 2048 * 2);
    p.wt3 = (bf16_t*)take((size_t)2048 * 2048 * 2);
    p.hy = (bf16_t*)take((size_t)NTOK * 2048 * 2);
    p.proj = (bf16_t*)take((size_t)NTOK * 8192 * 2);
    p.o = (bf16_t*)take((size_t)NTOK * 1024 * 2);
    p.mod = (float*)take((size_t)8 * 6144 * 4);
    p.ssq_h = (float*)take((size_t)NTOK * 64 * 4);
    p.ssq_o = (float*)take((size_t)NTOK * 32 * 4);
    p.bar = (unsigned*)take((size_t)XCD_BAR_WORDS * 4);
    p.img = take((size_t)2048 * IMG_BYTES);
    p.chk = (unsigned long long*)take(512);
    if (off > ws_size) return;
    p.merge = (bf16_t*)d_out;
    p.mix = p.proj;
    p.outpre = p.proj + (size_t)NTOK * 2048;
    p.tmp = (float*)(p.proj + (size_t)NTOK * 4096);
    static int grid_blocks = 0;
    if (!grid_blocks) {
        hipFuncSetAttribute((const void*)mega, hipFuncAttributeMaxDynamicSharedMemorySize, LDS_BYTES);
        int dev = 0, cus = 0, per_cu = 0;
        hipGetDevice(&dev);
        hipDeviceGetAttribute(&cus, hipDeviceAttributeMultiprocessorCount, dev);
        hipOccupancyMaxActiveBlocksPerMultiprocessor(&per_cu, mega, 512, LDS_BYTES);
        if (per_cu < 1) per_cu = 1;
        if (per_cu > 1) per_cu = 1;
        grid_blocks = cus * per_cu;
    }
#ifndef N_LAUNCH_SPLIT
#define N_LAUNCH_SPLIT 1
#endif
#if DIAG
    hipMemsetAsync(p.chk, 0, 128, stream);
#endif
    hipMemsetAsync(p.bar, 0, (size_t)XCD_BAR_WORDS * 4, stream);
    if (N_LAUNCH_SPLIT == 1) {
        p.ph_lo = 0; p.ph_hi = 8;
        void* args[] = {&p};
        hipError_t e = hipLaunchCooperativeKernel((void*)mega, dim3(grid_blocks), dim3(512), args, LDS_BYTES, stream);
        if (e != hipSuccess) fprintf(stderr, "cooperative launch failed: %s (grid %d)\n", hipGetErrorString(e), grid_blocks);
    } else {
        for (int ph = 0; ph < 8; ++ph) { p.ph_lo = ph; p.ph_hi = ph + 1; hipLaunchKernelGGL(mega, dim3(grid_blocks), dim3(512), LDS_BYTES, stream, p); }
    }
}
```
